# Optimizing an MI355X kernel written in HIP

```python
import jax, jax.numpy as jnp
from jax import lax
import numpy as np

D_MODEL = 1024
BATCH = 16
SEQ = 2048
DEPTH = 2
DEC_BATCH = 32
DEC_SEQ = 2048
PAST_LEN = 128

N_MIXERS = 2
N_FNET_LAYERS = (DEPTH + 1) // 2
N_LRU_LAYERS = DEPTH // 2
FNET_GROUPS = 4
FNET_GROUP_WIDTH = D_MODEL // FNET_GROUPS
D_RNN = 1280
LRU_BLOCKS = 10
LRU_BLOCK = D_RNN // LRU_BLOCKS
LRU_C = 8.0
LRU_CONV = 4
LRU_PAD_L, LRU_PAD_R = 2, 1
N_MEM = 256
XA_HEADS = 4
XA_HEAD_DIM = D_MODEL // XA_HEADS
D_FF = 2816
FFN_CONV = 3
EPS = 1e-6

kernel_name = "hybrid_fnet_rglru_xattn_encoder"


def _rmsnorm(x, g):
    xf = x.astype(jnp.float32)
    y = xf * lax.rsqrt(jnp.mean(xf * xf, axis=-1, keepdims=True) + EPS)
    return (y * g.astype(jnp.float32)).astype(x.dtype)


def _dwconv(x, w, b, pad_l, pad_r):
    s = x.shape[1]
    xp = jnp.pad(x, ((0, 0), (pad_l, pad_r), (0, 0)))
    out = xp[:, 0:s] * w[0]
    for k in range(1, w.shape[0]):
        out = out + xp[:, k:k + s] * w[k]
    return out + b


def _fourier_mixer(xn, w_out, b_out):
    bsz, s, d = xn.shape
    xg = xn.reshape(bsz, s, FNET_GROUPS, FNET_GROUP_WIDTH).astype(jnp.float32)
    f = jnp.fft.fft2(xg, axes=(1, 3), norm="ortho").real
    f = f.reshape(bsz, s, d).astype(xn.dtype)
    return f @ w_out + b_out


def _lin_combine(c1, c2):
    a1, b1 = c1
    a2, b2 = c2
    return a1 * a2, a2 * b1 + b2


def _rglru_mixer(xn, w_in, conv_w, conv_b, w_a, b_a, w_i, b_i, lam, w_out):
    bsz, s, _ = xn.shape
    u = xn @ w_in
    gate_br, rec_br = jnp.split(u, 2, axis=-1)
    gate = jax.nn.gelu(gate_br)
    c = _dwconv(rec_br, conv_w, conv_b, LRU_PAD_L, LRU_PAD_R)
    cb = c.reshape(bsz, s, LRU_BLOCKS, LRU_BLOCK)
    r = jax.nn.sigmoid((jnp.einsum('bshi,ehij->ebshj', cb, w_a).reshape(2, bsz, s, D_RNN)
                        + b_a[:, None, None, :]).astype(jnp.float32))
    ig = jax.nn.sigmoid((jnp.einsum('bshi,ehij->ebshj', cb, w_i).reshape(2, bsz, s, D_RNN)
                         + b_i[:, None, None, :]).astype(jnp.float32))
    log_a = -LRU_C * jax.nn.softplus(-lam.astype(jnp.float32))[:, None, None, :] * r
    a = jnp.exp(log_a)
    bterm = jnp.sqrt(-jnp.expm1(2.0 * log_a)) * (ig * c.astype(jnp.float32)[None])
    _, h_fwd = lax.associative_scan(_lin_combine, (a[0], bterm[0]), axis=1)
    _, h_bwd = lax.associative_scan(_lin_combine, (a[1], bterm[1]), axis=1, reverse=True)
    h = (h_fwd + h_bwd).astype(xn.dtype)
    return (h * gate) @ w_out


def _cross_attention(xn, mn, w_q, w_kv, w_o):
    bsz, s, d = xn.shape
    m = mn.shape[1]
    q = (xn @ w_q).reshape(bsz, s, XA_HEADS, XA_HEAD_DIM)
    k, v = jnp.split(mn @ w_kv, 2, axis=-1)
    k = k.reshape(bsz, m, XA_HEADS, XA_HEAD_DIM)
    v = v.reshape(bsz, m, XA_HEADS, XA_HEAD_DIM)
    scores = jnp.einsum('bshk,bmhk->bhsm', q, k).astype(jnp.float32) * (XA_HEAD_DIM ** -0.5)
    p = jax.nn.softmax(scores, axis=-1).astype(v.dtype)
    o = jnp.einsum('bhsm,bmhk->bshk', p, v).reshape(bsz, s, d)
    return o @ w_o


def _conv_ffn(xn, w_up, conv_w, conv_b, w_down):
    g, v = jnp.split(xn @ w_up, 2, axis=-1)
    g = _dwconv(g, conv_w, conv_b, FFN_CONV // 2, FFN_CONV // 2)
    return (jax.nn.gelu(g) * v) @ w_down


def _trunk(x, mem, p):
    for i in range(DEPTH):
        xn = _rmsnorm(x, p['norm_mix'][i])
        if i % N_MIXERS == 0:
            j = i // N_MIXERS
            x = x + _fourier_mixer(xn, p['fnet_w_out'][j], p['fnet_b_out'][j])
        else:
            j = i // N_MIXERS
            x = x + _rglru_mixer(xn, p['lru_w_in'][j], p['lru_conv_w'][j], p['lru_conv_b'][j],
                                 p['lru_w_a'][j], p['lru_b_a'][j], p['lru_w_i'][j], p['lru_b_i'][j],
                                 p['lru_lambda'][j], p['lru_w_out'][j])
        xn = _rmsnorm(x, p['norm_xa'][i])
        mn = _rmsnorm(mem, p['norm_mem'][i])
        x = x + _cross_attention(xn, mn, p['xa_w_q'][i], p['xa_w_kv'][i], p['xa_w_o'][i])
        xn = _rmsnorm(x, p['norm_ffn'][i])
        x = x + _conv_ffn(xn, p['ffn_w_up'][i], p['ffn_conv_w'][i], p['ffn_conv_b'][i], p['ffn_w_down'][i])
    return _rmsnorm(x, p['norm_final'])


def setup_inputs(seed: int = 0) -> dict:
    key = jax.random.key(seed)
    ks = jax.random.split(key, 32)
    f32 = jnp.float32

    def nrm(k, shape, fan_in):
        return jax.random.normal(k, shape, f32) * (fan_in ** -0.5)

    def gain(k, shape):
        return 1.0 + 0.02 * jax.random.normal(k, shape, f32)

    def small(k, shape):
        return 0.01 * jax.random.normal(k, shape, f32)

    u = jax.random.uniform(ks[12], (N_LRU_LAYERS, 2, D_RNN), f32, 0.9, 0.999)
    a0 = u ** (1.0 / LRU_C)
    lam = jnp.log(a0) - jnp.log1p(-a0)
    return {
        'x_prompt': jax.random.normal(ks[0], (BATCH, SEQ, D_MODEL), f32),
        'x_sample': jax.random.normal(ks[1], (DEC_BATCH, DEC_SEQ, D_MODEL), f32),
        'mem_prompt': jax.random.normal(ks[2], (BATCH, N_MEM, D_MODEL), f32),
        'mem_sample': jax.random.normal(ks[3], (DEC_BATCH, N_MEM, D_MODEL), f32),
        'norm_mix': gain(ks[4], (DEPTH, D_MODEL)),
        'fnet_w_out': nrm(ks[5], (N_FNET_LAYERS, D_MODEL, D_MODEL), D_MODEL),
        'fnet_b_out': small(ks[6], (N_FNET_LAYERS, D_MODEL)),
        'lru_w_in': nrm(ks[7], (N_LRU_LAYERS, D_MODEL, 2 * D_RNN), D_MODEL),
        'lru_conv_w': nrm(ks[8], (N_LRU_LAYERS, LRU_CONV, D_RNN), LRU_CONV),
        'lru_conv_b': small(ks[9], (N_LRU_LAYERS, D_RNN)),
        'lru_w_a': nrm(ks[10], (N_LRU_LAYERS, 2, LRU_BLOCKS, LRU_BLOCK, LRU_BLOCK), LRU_BLOCK),
        'lru_b_a': small(ks[11], (N_LRU_LAYERS, 2, D_RNN)),
        'lru_w_i': nrm(ks[13], (N_LRU_LAYERS, 2, LRU_BLOCKS, LRU_BLOCK, LRU_BLOCK), LRU_BLOCK),
        'lru_b_i': small(ks[14], (N_LRU_LAYERS, 2, D_RNN)),
        'lru_lambda': lam,
        'lru_w_out': nrm(ks[15], (N_LRU_LAYERS, D_RNN, D_MODEL), D_RNN),
        'norm_xa': gain(ks[16], (DEPTH, D_MODEL)),
        'norm_mem': gain(ks[17], (DEPTH, D_MODEL)),
        'xa_w_q': nrm(ks[18], (DEPTH, D_MODEL, D_MODEL), D_MODEL),
        'xa_w_kv': nrm(ks[19], (DEPTH, D_MODEL, 2 * D_MODEL), D_MODEL),
        'xa_w_o': nrm(ks[20], (DEPTH, D_MODEL, D_MODEL), D_MODEL),
        'norm_ffn': gain(ks[21], (DEPTH, D_MODEL)),
        'ffn_w_up': nrm(ks[22], (DEPTH, D_MODEL, 2 * D_FF), D_MODEL),
        'ffn_conv_w': nrm(ks[23], (DEPTH, FFN_CONV, D_FF), FFN_CONV),
        'ffn_conv_b': small(ks[24], (DEPTH, D_FF)),
        'ffn_w_down': nrm(ks[25], (DEPTH, D_FF, D_MODEL), D_FF),
        'norm_final': gain(ks[26], (D_MODEL,)),
    }


def reference(x_prompt, x_sample, mem_prompt, mem_sample, norm_mix, fnet_w_out, fnet_b_out,
              lru_w_in, lru_conv_w, lru_conv_b, lru_w_a, lru_b_a, lru_w_i, lru_b_i, lru_lambda,
              lru_w_out, norm_xa, norm_mem, xa_w_q, xa_w_kv, xa_w_o, norm_ffn, ffn_w_up,
              ffn_conv_w, ffn_conv_b, ffn_w_down, norm_final):
    params = {
        'norm_mix': norm_mix, 'fnet_w_out': fnet_w_out, 'fnet_b_out': fnet_b_out,
        'lru_w_in': lru_w_in, 'lru_conv_w': lru_conv_w, 'lru_conv_b': lru_conv_b,
        'lru_w_a': lru_w_a, 'lru_b_a': lru_b_a, 'lru_w_i': lru_w_i, 'lru_b_i': lru_b_i,
        'lru_lambda': lru_lambda, 'lru_w_out': lru_w_out,
        'norm_xa': norm_xa, 'norm_mem': norm_mem, 'xa_w_q': xa_w_q, 'xa_w_kv': xa_w_kv, 'xa_w_o': xa_w_o,
        'norm_ffn': norm_ffn, 'ffn_w_up': ffn_w_up, 'ffn_conv_w': ffn_conv_w, 'ffn_conv_b': ffn_conv_b,
        'ffn_w_down': ffn_w_down, 'norm_final': norm_final,
    }
    y_prompt = _trunk(x_prompt, mem_prompt, params)
    y_sample = _trunk(x_sample, mem_sample, params)
    return (y_prompt, y_sample)
```

```cpp
#include <hip/hip_runtime.h>
#include <hip/hip_cooperative_groups.h>
#include <cstdio>
namespace cg = cooperative_groups;

#define LAS __attribute__((address_space(3)))
typedef unsigned short bf16_t;
typedef short bf16x8 __attribute__((ext_vector_type(8)));
typedef float f32x4 __attribute__((ext_vector_type(4)));
typedef unsigned u32x4 __attribute__((ext_vector_type(4)));
typedef unsigned u32x2 __attribute__((ext_vector_type(2)));

constexpr int BM = 256, BK = 64, HALF = 128, HTB = HALF * BK * 2, STAGE_BYTES = 8 * HTB;
constexpr int LDS_BYTES = STAGE_BYTES + 8192;
constexpr int NB = 48, SEQ = 2048, DM = 1024, NMEM = 256, DRNN = 1280, DFF = 2816;

__device__ __forceinline__ int lds_byte(int r, int c) { const int st = (r >> 4) * 2 + (c >> 5), rr = r & 15, cc = c & 31, ob = rr * 64 + cc * 2; return st * 1024 + (ob ^ (((ob >> 9) & 1) << 5)); }
__device__ __forceinline__ void stage_rc(int b, int& R, int& C) { const int st = b / 1024, sb = b % 1024, swz = sb ^ (((sb >> 9) & 1) << 5); R = (st >> 1) * 16 + swz / 64; C = (st & 1) * 32 + (swz % 64) / 2; }
__device__ __forceinline__ int perm32(int rho) { const int n = rho >> 4, i = rho & 15; return 8 * (i >> 2) + 4 * n + (i & 3); }
__device__ __forceinline__ unsigned cvt_pk_bf16(float lo, float hi) { unsigned r; asm volatile("v_cvt_pk_bf16_f32 %0, %1, %2" : "=v"(r) : "v"(lo), "v"(hi)); return r; }
__device__ __forceinline__ bf16_t f2bf(float f) { unsigned u = __float_as_uint(f); u += 0x7FFFu + ((u >> 16) & 1u); return (bf16_t)(u >> 16); }
__device__ __forceinline__ float bf2f(bf16_t b) { return __uint_as_float(((unsigned)b) << 16); }
__device__ __forceinline__ float bflo(unsigned w) { return __uint_as_float(w << 16); }
__device__ __forceinline__ float bfhi(unsigned w) { return __uint_as_float(w & 0xffff0000u); }
__device__ __forceinline__ float gelu_tanh(float x) { const float u = 1.5957691216f * (x + 0.044715f * x * x * x); return x * __builtin_amdgcn_rcpf(1.0f + __expf(-u)); }
typedef float f32x2 __attribute__((ext_vector_type(2)));
__device__ __forceinline__ f32x2 gelu_tanh2(f32x2 x) {
    const f32x2 t = x * x;
    const f32x2 w = x * (t * (-0.10294324f) + (-2.3022082f));
    f32x2 e; e.x = __builtin_amdgcn_exp2f(w.x); e.y = __builtin_amdgcn_exp2f(w.y);
    const f32x2 d = e + 1.0f;
    f32x2 r; r.x = __builtin_amdgcn_rcpf(d.x); r.y = __builtin_amdgcn_rcpf(d.y);
    return x * r;
}
__device__ __forceinline__ int tid_() { int t = threadIdx.x; asm volatile("" : "+v"(t)); return t; }
__device__ __forceinline__ float sigmoidf(float z) { return __builtin_amdgcn_rcpf(1.0f + __expf(-z)); }


struct GemmDesc {
    const char* A; const char* B; char* C; const float* bias;
    unsigned aZ1, aZ2, bZ1, bZ2, aTile, bTile, cZ1, cZ2;
    unsigned aCh, bCh, cCh;
    int nM, nN, nZ, zdiv, K, lda, ldb, ldc, epi, gelu_pn, bhalf;
    unsigned mper, mnig, mgsz, mzdiv, padm;
};
struct Params {
    const float* in[27];
    float* out;
    bf16_t* wp[14];
    unsigned char* R1;
    float* c8sp;
    bf16_t* xr;
    float* edge;
    unsigned* bar;
    int CB, nch;
    unsigned char kind[32]; unsigned char arg[32];
    GemmDesc g[20];
};
enum { WP_FNET = 0, WP_IN, WP_GATE, WP_LOUT, WP_Q, WP_KV, WP_O, WP_UP, WP_DOWN, WP_CS, WP_DFTA, WP_MN, WP_R0, WP_PAD };
enum { K_GEMM = 0, K_PROLOGUE, K_RMS_IN, K_RMS_XA, K_RMS_FFN, K_RMS_MIX1, K_SOFTMAX, K_FFNCONV, K_FFNFIX, K_LRU, K_LRUCONV, K_SCAN, K_FINAL };
enum { E_BF16 = 0, E_F32, E_RESID, E_GATE, E_SOFTMAX, E_FFN, E_DFT };

struct Unit { const char* A; const char* B; int pm, pn, z1, z2; };

__device__ __forceinline__ void epi_bf16(const f32x4 (&acc)[2][2][4][2], const Unit& u, char* Cb, unsigned cZ1, unsigned cZ2, int ldc, int gelu_pn, int wr, int wc, int fr, int fq) {
    bf16_t* base = (bf16_t*)(Cb + (size_t)u.z1 * cZ1 + (size_t)u.z2 * cZ2) + (long)(u.pm * BM + wr * 64 + fr) * ldc + u.pn * BM + wc * 32 + 8 * fq;
    const bool g = u.pn < gelu_pn;
#pragma unroll
    for (int ai = 0; ai < 2; ++ai)
#pragma unroll
        for (int m = 0; m < 4; ++m) { bf16_t* rowp = base + (long)(ai * HALF + m * 16) * ldc;
#pragma unroll
            for (int bj = 0; bj < 2; ++bj) { f32x4 v0 = acc[ai][bj][m][0], v1 = acc[ai][bj][m][1];
                if (g) {
                    const f32x2 a = gelu_tanh2((f32x2){v0[0], v0[1]}), b = gelu_tanh2((f32x2){v0[2], v0[3]}), c = gelu_tanh2((f32x2){v1[0], v1[1]}), d = gelu_tanh2((f32x2){v1[2], v1[3]});
                    v0 = (f32x4){a.x, a.y, b.x, b.y}; v1 = (f32x4){c.x, c.y, d.x, d.y}; }
                u32x4 w; w.x = cvt_pk_bf16(v0[0], v0[1]); w.y = cvt_pk_bf16(v0[2], v0[3]); w.z = cvt_pk_bf16(v1[0], v1[1]); w.w = cvt_pk_bf16(v1[2], v1[3]);
                *(u32x4*)(rowp + bj * HALF) = w; } }
}
__device__ __forceinline__ void epi_f32(const f32x4 (&acc)[2][2][4][2], const Unit& u, char* Cb, unsigned cZ1, unsigned cZ2, int ldc, int wr, int wc, int fr, int fq) {
    float* base = (float*)(Cb + (size_t)u.z1 * cZ1 + (size_t)u.z2 * cZ2) + (long)(u.pm * BM + wr * 64 + fr) * ldc + u.pn * BM + wc * 32 + 4 * fq;
#pragma unroll
    for (int ai = 0; ai < 2; ++ai)
#pragma unroll
        for (int m = 0; m < 4; ++m) { float* rowp = base + (long)(ai * HALF + m * 16) * ldc;
#pragma unroll
            for (int bj = 0; bj < 2; ++bj)
#pragma unroll
                for (int n = 0; n < 2; ++n) *(f32x4*)(rowp + bj * HALF + n * 16) = acc[ai][bj][m][n]; }
}
__device__ __forceinline__ void epi_resid(const f32x4 (&acc)[2][2][4][2], const Unit& u, char* Cb, int ldc, const float* bias, int wr, int wc, int fr, int fq) {
    const int col0 = u.pn * BM + wc * 32 + 8 * fq;
    bf16_t* base = (bf16_t*)Cb + (long)(u.pm * BM + wr * 64 + fr) * ldc + col0;
#pragma unroll
    for (int bj = 0; bj < 2; ++bj) {
        const f32x4 b0 = bias ? *(const f32x4*)(bias + col0 + bj * HALF) : (f32x4){0.f, 0.f, 0.f, 0.f};
        const f32x4 b1 = bias ? *(const f32x4*)(bias + col0 + bj * HALF + 4) : (f32x4){0.f, 0.f, 0.f, 0.f};
#pragma unroll
        for (int ai = 0; ai < 2; ++ai)
#pragma unroll
            for (int m = 0; m < 4; ++m) { u32x4* q = (u32x4*)(base + (long)(ai * HALF + m * 16) * ldc + bj * HALF);
                const u32x4 x = *q; const f32x4 a0 = acc[ai][bj][m][0], a1 = acc[ai][bj][m][1];
                u32x4 w;
                w.x = cvt_pk_bf16(bflo(x.x) + a0[0] + b0[0], bfhi(x.x) + a0[1] + b0[1]); w.y = cvt_pk_bf16(bflo(x.y) + a0[2] + b0[2], bfhi(x.y) + a0[3] + b0[3]);
                w.z = cvt_pk_bf16(bflo(x.z) + a1[0] + b1[0], bfhi(x.z) + a1[1] + b1[1]); w.w = cvt_pk_bf16(bflo(x.w) + a1[2] + b1[2], bfhi(x.w) + a1[3] + b1[3]);
                *q = w; } }
}

__device__ __forceinline__ void epi_softmax(const f32x4 (&acc)[2][2][4][2], const Unit& u, char* Cb, unsigned cZ1, unsigned cZ2, int ldc, LAS float* rs, int wr, int wc, int fr, int fq) {
#pragma unroll
    for (int ai = 0; ai < 2; ++ai)
#pragma unroll
        for (int m = 0; m < 4; ++m) { float s = 0.f;
#pragma unroll
            for (int bj = 0; bj < 2; ++bj)
#pragma unroll
                for (int n = 0; n < 2; ++n)
#pragma unroll
                    for (int j = 0; j < 4; ++j) s += __expf(acc[ai][bj][m][n][j]);
            s += __shfl_xor(s, 16, 64); s += __shfl_xor(s, 32, 64);
            if (fq == 0) rs[((wr * 128 + ai * 64 + m * 16 + fr) << 2) + wc] = s; }
    asm volatile("s_waitcnt lgkmcnt(0)" ::: "memory");
    __builtin_amdgcn_s_barrier();
    __builtin_amdgcn_sched_barrier(0);
    asm volatile("" : "+s"(ldc) :: "memory");
    bf16_t* base = (bf16_t*)(Cb + (size_t)u.z1 * cZ1 + (size_t)u.z2 * cZ2) + (long)(u.pm * BM + wr * 64 + fr) * ldc + u.pn * BM + wc * 32 + 8 * fq;
#pragma unroll
    for (int ai = 0; ai < 2; ++ai)
#pragma unroll
        for (int m = 0; m < 4; ++m) {
            const f32x4 t = *(const LAS f32x4*)&rs[(wr * 128 + ai * 64 + m * 16 + fr) << 2];
            const float lg = __logf(t[0] + t[1] + t[2] + t[3]);
            bf16_t* rowp = base + (long)(ai * HALF + m * 16) * ldc;
#pragma unroll
            for (int bj = 0; bj < 2; ++bj) { f32x4 v0, v1;
#pragma unroll
                for (int j = 0; j < 4; ++j) { v0[j] = __expf(acc[ai][bj][m][0][j] - lg); v1[j] = __expf(acc[ai][bj][m][1][j] - lg); }
                u32x4 w; w.x = cvt_pk_bf16(v0[0], v0[1]); w.y = cvt_pk_bf16(v0[2], v0[3]); w.z = cvt_pk_bf16(v1[0], v1[1]); w.w = cvt_pk_bf16(v1[2], v1[3]);
                *(u32x4*)(rowp + bj * HALF) = w; } }
}

__device__ __forceinline__ float dpp_ror1(float x) { return __builtin_bit_cast(float, __builtin_amdgcn_mov_dpp(__builtin_bit_cast(int, x), 0x121, 0xf, 0xf, true)); }
__device__ __forceinline__ float dpp_rol1(float x) { return __builtin_bit_cast(float, __builtin_amdgcn_mov_dpp(__builtin_bit_cast(int, x), 0x12F, 0xf, 0xf, true)); }
__device__ __forceinline__ void epi_ffn(const f32x4 (&acc)[2][2][4][2], const Unit& u, char* Cb, const float* __restrict__ cw, const float* __restrict__ cb, float* __restrict__ edge, long edgeN,
                                        LAS float* E, int wr, int wc, int fr, int fq) {
    const int cl = wc * 32 + 4 * fq;
#pragma unroll
    for (int ai = 0; ai < 2; ++ai)
#pragma unroll
        for (int n = 0; n < 2; ++n) {
            if (fr == 0)  *(LAS f32x4*)&E[((wr * 2 + ai) * 2 + 0) * 128 + cl + 16 * n] = acc[ai][0][0][n];
            if (fr == 15) *(LAS f32x4*)&E[((wr * 2 + ai) * 2 + 1) * 128 + cl + 16 * n] = acc[ai][0][3][n];
        }
    asm volatile("s_waitcnt lgkmcnt(0)" ::: "memory");
    __builtin_amdgcn_s_barrier();
    __builtin_amdgcn_s_barrier();
    __builtin_amdgcn_sched_barrier(0);
    const int f0 = u.pn * 128 + cl;
    bf16_t* hbase = (bf16_t*)Cb + (long)(u.pm * BM + wr * 64 + fr) * DFF + f0;
#pragma unroll
    for (int n = 0; n < 2; ++n) {
        const f32x4 w0 = *(const f32x4*)(cw + f0 + 16 * n), w1 = *(const f32x4*)(cw + DFF + f0 + 16 * n), w2 = *(const f32x4*)(cw + 2 * DFF + f0 + 16 * n), bb = *(const f32x4*)(cb + f0 + 16 * n);
#pragma unroll
        for (int ai = 0; ai < 2; ++ai) {
            const f32x4 zero = {0.f, 0.f, 0.f, 0.f};
            f32x4 bup, bdn;
            if (wr == 1) bup = *(const LAS f32x4*)&E[((0 * 2 + ai) * 2 + 1) * 128 + cl + 16 * n];
            else if (ai == 1) bup = *(const LAS f32x4*)&E[((1 * 2 + 0) * 2 + 1) * 128 + cl + 16 * n];
            else bup = zero;
            if (wr == 0) bdn = *(const LAS f32x4*)&E[((1 * 2 + ai) * 2 + 0) * 128 + cl + 16 * n];
            else if (ai == 0) bdn = *(const LAS f32x4*)&E[((0 * 2 + 1) * 2 + 0) * 128 + cl + 16 * n];
            else bdn = zero;
            f32x4 r1[4], l1[4];
#pragma unroll
            for (int m = 0; m < 4; ++m)
#pragma unroll
                for (int j = 0; j < 4; ++j) { r1[m][j] = dpp_ror1(acc[ai][0][m][n][j]); l1[m][j] = dpp_rol1(acc[ai][0][m][n][j]); }
#pragma unroll
            for (int m = 0; m < 4; ++m) {
                const f32x4 g = acc[ai][0][m][n], v = acc[ai][1][m][n];
                const f32x4 upw = (m > 0) ? r1[m > 0 ? m - 1 : 0] : bup, dnw = (m < 3) ? l1[m < 3 ? m + 1 : 3] : bdn;
                f32x4 cv; float o[4];
#pragma unroll
                for (int jp = 0; jp < 2; ++jp) {
                    f32x2 up2, dn2;
                    up2.x = (fr == 0) ? upw[2 * jp] : r1[m][2 * jp]; up2.y = (fr == 0) ? upw[2 * jp + 1] : r1[m][2 * jp + 1];
                    dn2.x = (fr == 15) ? dnw[2 * jp] : l1[m][2 * jp]; dn2.y = (fr == 15) ? dnw[2 * jp + 1] : l1[m][2 * jp + 1];
                    const f32x2 g2 = {g[2 * jp], g[2 * jp + 1]}, v2 = {v[2 * jp], v[2 * jp + 1]};
                    const f32x2 w0p = {w0[2 * jp], w0[2 * jp + 1]}, w1p = {w1[2 * jp], w1[2 * jp + 1]}, w2p = {w2[2 * jp], w2[2 * jp + 1]}, bbp = {bb[2 * jp], bb[2 * jp + 1]};
                    const f32x2 c2 = w0p * up2 + (w1p * g2 + (w2p * dn2 + bbp));
                    const f32x2 o2 = gelu_tanh2(c2) * v2;
                    cv[2 * jp] = c2.x; cv[2 * jp + 1] = c2.y; o[2 * jp] = o2.x; o[2 * jp + 1] = o2.y;
                }
                u32x2 w; w.x = cvt_pk_bf16(o[0], o[1]); w.y = cvt_pk_bf16(o[2], o[3]);
                *(u32x2*)(hbase + (long)(ai * HALF + m * 16) * DFF + 16 * n) = w;
                if (ai == 0 && m == 0 && wr == 0 && fr == 0) {
                    float* e0 = edge + ((long)u.pm * 2 + 0) * DFF + f0 + 16 * n;
                    *(f32x4*)e0 = g; *(f32x4*)(e0 + edgeN) = cv; *(f32x4*)(e0 + 2 * edgeN) = v; }
                if (ai == 1 && m == 3 && wr == 1 && fr == 15) {
                    float* e1 = edge + ((long)u.pm * 2 + 1) * DFF + f0 + 16 * n;
                    *(f32x4*)e1 = g; *(f32x4*)(e1 + edgeN) = cv; *(f32x4*)(e1 + 2 * edgeN) = v; }
            }
        }
    }
}

__device__ __forceinline__ void epi_dft(const f32x4 (&acc)[2][2][4][2], const Unit& u, char* Cb, unsigned cZ1, int wr, int wc, int fr, int fq) {
    asm volatile("" : "+v"(fq), "+v"(fr));
    bf16_t* fb = (bf16_t*)(Cb + (size_t)u.z1 * cZ1) + u.pn * BM;
    const int r0 = u.pm * BM + wr * 64 + fr;
#pragma unroll
    for (int ai = 0; ai < 2; ++ai)
#pragma unroll
        for (int m = 0; m < 4; ++m) {
            const int s = r0 + ai * HALF + m * 16;
            bf16_t* rowp = fb + (long)s * DM;
            bf16_t* mir = fb + (long)(SEQ - s) * DM;
#pragma unroll
            for (int bj = 0; bj < 2; ++bj) {
                const int c0 = bj * HALF + wc * 32 + 8 * fq;
                const f32x4 v0 = acc[ai][bj][m][0], v1 = acc[ai][bj][m][1];
                u32x4 w; w.x = cvt_pk_bf16(v0[0], v0[1]); w.y = cvt_pk_bf16(v0[2], v0[3]); w.z = cvt_pk_bf16(v1[0], v1[1]); w.w = cvt_pk_bf16(v1[2], v1[3]);
                *(u32x4*)(rowp + c0) = w;
                if (s != 0) {
                    bf16_t* mg = mir + (248 - c0);
                    mg[1] = (bf16_t)(w.w >> 16);
                    *(unsigned*)(mg + 2) = cvt_pk_bf16(v1[2], v1[1]);
                    u32x2 t; t.x = cvt_pk_bf16(v1[0], v0[3]); t.y = cvt_pk_bf16(v0[2], v0[1]);
                    *(u32x2*)(mg + 4) = t;
                    mir[(256 - c0) & 255] = (bf16_t)(w.x & 0xffffu);
                }
            }
        }
}
__device__ __forceinline__ void epi_gate(const f32x4 (&acc)[2][2][4][2], const Unit& u, const bf16_t* cbuf, unsigned* LB, const float* b_a, const float* b_i, const float* c8sp, long Tc,
                                         int wr, int wc, int fr, int fq) {
    const int e = u.z1, h = u.z2;
#pragma unroll
    for (int n = 0; n < 2; ++n) {
        const int ch = h * 128 + wc * 32 + 8 * fq + 4 * n;
        const f32x4 ba = *(const f32x4*)(b_a + e * DRNN + ch), bi = *(const f32x4*)(b_i + e * DRNN + ch), sp = *(const f32x4*)(c8sp + e * DRNN + ch);
#pragma unroll
        for (int ai = 0; ai < 2; ++ai)
#pragma unroll
            for (int m = 0; m < 4; ++m) {
                const long row = (long)u.pm * BM + ai * HALF + wr * 64 + m * 16 + fr;
                const u32x2 cw = *(const u32x2*)(cbuf + row * DRNN + ch);
                const float cv[4] = {bflo(cw.x), bfhi(cw.x), bflo(cw.y), bfhi(cw.y)};
                u32x4 w;
#pragma unroll
                for (int j = 0; j < 4; ++j) {
                    const float r = sigmoidf(acc[ai][0][m][n][j] + ba[j]);
                    const float ig = sigmoidf(acc[ai][1][m][n][j] + bi[j]);
                    const float la = -sp[j] * r;
                    const float a2 = __expf(2.0f * la);
                    w[j] = cvt_pk_bf16(la, __builtin_sqrtf(fmaxf(1.0f - a2, 0.f)) * ig * cv[j]);
                }
                *(u32x4*)(LB + ((long)e * Tc + row) * DRNN + ch) = w;
            }
    }
}

__device__ __forceinline__ void gemm_phase(const int bid, const int nblk, LAS unsigned char* lds, const int garg, const int chunk, const Params& p) {
    const GemmDesc& d = p.g[garg];
    const int tid = tid_(), wid = __builtin_amdgcn_readfirstlane(tid >> 6), lane = tid & 63, wr = wid >> 2, wc = wid & 3, fr = lane & 15, fq = lane >> 4;
    const int K = d.K, lda = d.lda, ldb = d.ldb, epi = d.epi, nt = K / BK;
    const int nM = d.nM, nN = d.nN, zdiv = d.zdiv, nwg = nM * nN * d.nZ;
    const char* Ab = d.A + (size_t)chunk * d.aCh; const char* Bb = d.B + (size_t)chunk * d.bCh;
    const unsigned aZ1 = d.aZ1, aZ2 = d.aZ2, bZ1 = d.bZ1, bZ2 = d.bZ2, aTile = d.aTile, bTile = d.bTile;
    const unsigned mper = d.mper, mnig = d.mnig, mgsz = d.mgsz, mzdiv = d.mzdiv;
    const int per = nM * nN, nig = 8 * nN, gsz = nM < 8 ? nM : 8, q8 = nwg >> 3, r8 = nwg & 7;
    auto next = [&](int i, Unit& u) -> bool {
        const long L = (long)i * nblk + bid; if (L >= nwg) return false;
        int w = (int)L; { const int xcd = w & 7, off = w >> 3; w = (xcd < r8 ? xcd * (q8 + 1) : r8 * (q8 + 1) + (xcd - r8) * q8) + off; }
        const int z = (int)__umulhi((unsigned)w, mper), loc = w - z * per;
        const int gid = (int)__umulhi((unsigned)loc, mnig), lr = loc - gid * nig;
        const int pn = (int)__umulhi((unsigned)lr, mgsz), pm = gid * 8 + lr - pn * gsz;
        const int z1 = zdiv == 1 ? z : (int)__umulhi((unsigned)z, mzdiv), z2 = z - z1 * zdiv;
        u.A = Ab + (size_t)z1 * aZ1 + (size_t)z2 * aZ2 + (size_t)pm * aTile; u.B = Bb + (size_t)z1 * bZ1 + (size_t)z2 * bZ2 + (size_t)pn * bTile;
        u.pm = pm; u.pn = pn; u.z1 = z1; u.z2 = z2; return true;
    };
    unsigned voffA[2], voffB[2];
#pragma unroll
    for (int i = 0; i < 2; ++i) { int R, C; stage_rc(tid * 16 + i * 8192, R, C); const int Rb = (epi != E_F32 && epi != E_FFN) ? ((R & ~31) + perm32(R & 31)) : R;
        voffA[i] = (unsigned)(R * lda + C) * 2u; voffB[i] = (unsigned)(Rb * ldb + C) * 2u; }
    const size_t kstep = (size_t)(BK * 2);
    const size_t hstepA = (size_t)HALF * lda * 2, hstepB = (size_t)d.bhalf * ldb * 2;
    const unsigned ldsw = (unsigned)wid * 1024u;
    const int aoff = lds_byte(wr * 64 + fr, fq * 8), boff = lds_byte(wc * 32 + fr, fq * 8);
#define PG8_SA(b, h) (((b) * 2 + (h)) * HTB)
#define PG8_SB(b, h) ((4 + (b) * 2 + (h)) * HTB)
#define PG8_STAGE(bufoff, gbase, voff) do { _Pragma("unroll") for (int _i = 0; _i < 2; ++_i) \
        __builtin_amdgcn_global_load_lds((const unsigned*)((const char*)(gbase) + (voff)[_i]), (LAS unsigned*)(lds + (bufoff) + ldsw + _i * 8192), 16, 0, 0); } while (0)
#define PG8_LDA(dst, b, h) do { _Pragma("unroll") for (int m = 0; m < 4; ++m) _Pragma("unroll") for (int k = 0; k < 2; ++k) dst[m][k] = *(const LAS bf16x8*)(lds + PG8_SA(b, h) + aoff + m * 2048 + k * 1024); } while (0)
#define PG8_LDB(dst, b, h) do { _Pragma("unroll") for (int n = 0; n < 2; ++n) _Pragma("unroll") for (int k = 0; k < 2; ++k) dst[n][k] = *(const LAS bf16x8*)(lds + PG8_SB(b, h) + boff + n * 2048 + k * 1024); } while (0)
#define PG8_MMA(ai, bj, At, Bt) do { __builtin_amdgcn_s_setprio(1); _Pragma("unroll") for (int m = 0; m < 4; ++m) _Pragma("unroll") for (int n = 0; n < 2; ++n) _Pragma("unroll") for (int k = 0; k < 2; ++k) \
        acc[ai][bj][m][n] = __builtin_amdgcn_mfma_f32_16x16x32_bf16(Bt[n][k], At[m][k], acc[ai][bj][m][n], 0, 0, 0); __builtin_amdgcn_s_setprio(0); } while (0)
#define PG8_WAIT_V(n) asm volatile("s_waitcnt vmcnt(" #n ")" ::: "memory")
#define PG8_WAIT_L(n) asm volatile("s_waitcnt lgkmcnt(" #n ")" ::: "memory")
#define PG8_BAR __builtin_amdgcn_s_barrier()
#define PG8_SCHED __builtin_amdgcn_sched_barrier(0)
    Unit cur, nxt; int ui = 0;
    if (!next(0, cur)) return;
    f32x4 acc[2][2][4][2];
#pragma unroll
    for (int a = 0; a < 2; ++a)
#pragma unroll
        for (int b = 0; b < 2; ++b)
#pragma unroll
            for (int m = 0; m < 4; ++m)
#pragma unroll
                for (int n = 0; n < 2; ++n) acc[a][b][m][n] = (f32x4){0.f, 0.f, 0.f, 0.f};
    bf16x8 At[4][2], B0[2][2], B1[2][2];
    const char* cA = cur.A; const char* cB = cur.B;
    PG8_STAGE(PG8_SB(0, 0), cB, voffB); PG8_STAGE(PG8_SA(0, 0), cA, voffA); PG8_STAGE(PG8_SB(0, 1), cB + hstepB, voffB); PG8_STAGE(PG8_SA(0, 1), cA + hstepA, voffA);
    if (wr == 1) PG8_BAR;
    PG8_WAIT_V(4); PG8_BAR;
    PG8_STAGE(PG8_SB(1, 0), cB + kstep, voffB); PG8_STAGE(PG8_SA(1, 0), cA + kstep, voffA); PG8_STAGE(PG8_SB(1, 1), cB + hstepB + kstep, voffB);
    PG8_WAIT_V(6); PG8_BAR;
    for (;;) {
        const bool has_next = next(ui + 1, nxt);
        const char* nA = has_next ? nxt.A : cA; const char* nB = has_next ? nxt.B : cB;
        for (int t = 0; t < nt; t += 2) {
            const bool last = (t == nt - 2);
            const char* a1 = cA + (size_t)(t + 1) * kstep;
            const char* a2 = last ? nA : cA + (size_t)(t + 2) * kstep; const char* b2 = last ? nB : cB + (size_t)(t + 2) * kstep;
            const char* a3 = a2 + kstep; const char* b3 = b2 + kstep;
            PG8_LDB(B0, 0, 0); PG8_SCHED; PG8_LDA(At, 0, 0); PG8_STAGE(PG8_SA(1, 1), a1 + hstepA, voffA);
            PG8_WAIT_L(8); PG8_BAR; PG8_WAIT_L(0); PG8_MMA(0, 0, At, B0); PG8_BAR; PG8_SCHED;
            PG8_LDB(B1, 0, 1); PG8_STAGE(PG8_SB(0, 0), b2, voffB);
            PG8_BAR; PG8_WAIT_L(0); PG8_MMA(0, 1, At, B1); PG8_BAR;
            PG8_LDA(At, 0, 1); PG8_STAGE(PG8_SA(0, 0), a2, voffA);
            PG8_BAR; PG8_WAIT_L(0); PG8_MMA(1, 0, At, B0); PG8_BAR; PG8_SCHED;
            PG8_STAGE(PG8_SB(0, 1), b2 + hstepB, voffB);
            PG8_WAIT_V(6); PG8_BAR; PG8_MMA(1, 1, At, B1); PG8_BAR;
            PG8_LDB(B0, 1, 0); PG8_SCHED; PG8_LDA(At, 1, 0); PG8_STAGE(PG8_SA(0, 1), a2 + hstepA, voffA);
            PG8_WAIT_L(8); PG8_BAR; PG8_WAIT_L(0); PG8_MMA(0, 0, At, B0); PG8_BAR; PG8_SCHED;
            PG8_LDB(B1, 1, 1); PG8_STAGE(PG8_SB(1, 0), b3, voffB);
            PG8_BAR; PG8_WAIT_L(0); PG8_MMA(0, 1, At, B1); PG8_BAR;
            PG8_LDA(At, 1, 1); PG8_STAGE(PG8_SA(1, 0), a3, voffA);
            PG8_BAR; PG8_WAIT_L(0); PG8_MMA(1, 0, At, B0); PG8_BAR; PG8_SCHED;
            PG8_STAGE(PG8_SB(1, 1), b3 + hstepB, voffB);
            PG8_WAIT_V(6); PG8_BAR; PG8_MMA(1, 1, At, B1); PG8_BAR;
        }
        {
            int zE; asm volatile("s_mov_b32 %0, 0" : "=s"(zE));
            const GemmDesc& de = p.g[garg + zE];
            char* Cb = de.C + (size_t)chunk * de.cCh;
            if (epi == E_BF16) epi_bf16(acc, cur, Cb, de.cZ1, de.cZ2, de.ldc, de.gelu_pn, wr, wc, fr, fq);
            else if (epi == E_RESID) epi_resid(acc, cur, Cb, de.ldc, de.bias, wr, wc, fr, fq);
            else if (epi == E_F32) epi_f32(acc, cur, Cb, de.cZ1, de.cZ2, de.ldc, wr, wc, fr, fq);
            else if (epi == E_DFT) epi_dft(acc, cur, Cb, de.cZ1, wr, wc, fr, fq);
            else if (epi == E_FFN) { const int layer = de.gelu_pn; epi_ffn(acc, cur, Cb, p.in[23 + zE] + layer * 3 * DFF, p.in[24 + zE] + layer * DFF, p.edge + zE, (long)de.nM * 2 * DFF, (LAS float*)(lds + STAGE_BYTES), wr, wc, fr, fq); }
            else if (epi == E_SOFTMAX) epi_softmax(acc, cur, Cb, de.cZ1, de.cZ2, de.ldc, (LAS float*)(lds + STAGE_BYTES), wr, wc, fr, fq);
            else { const long Tc = (long)(p.CB + zE) * SEQ; epi_gate(acc, cur, (const bf16_t*)(de.A + (size_t)chunk * de.aCh), (unsigned*)Cb, p.in[11 + zE], p.in[13 + zE], p.c8sp + zE, Tc, wr, wc, fr, fq); }
        }
        if (!has_next) break;
#pragma unroll
        for (int a = 0; a < 2; ++a)
#pragma unroll
            for (int b = 0; b < 2; ++b)
#pragma unroll
                for (int m = 0; m < 4; ++m)
#pragma unroll
                    for (int n = 0; n < 2; ++n) acc[a][b][m][n] = (f32x4){0.f, 0.f, 0.f, 0.f};
        cur = nxt; cA = nA; cB = nB; ++ui;
    }
    PG8_WAIT_V(0);
    if (wr == 0) PG8_BAR;
    PG8_BAR;
#undef PG8_SA
#undef PG8_SB
#undef PG8_STAGE
#undef PG8_LDA
#undef PG8_LDB
#undef PG8_MMA
#undef PG8_WAIT_V
#undef PG8_WAIT_L
#undef PG8_BAR
#undef PG8_SCHED
}

__device__ void transpose_job(const int bid, const int nblk, float* tile, const float* __restrict__ src, bf16_t* __restrict__ dst, int K, int N, int nb, long dstB, float scale) {
    const int tk = K / 64, tn = N / 64, per = tk * tn, tot = per * nb, tid = tid_();
    const int kk = tid >> 6, nn = tid & 63;
    float r[8];
    int t = bid;
    if (t < tot) { const int b = t / per, l = t - b * per, k0 = (l / tn) * 64, n0 = (l % tn) * 64; const float* s = src + (long)b * K * N;
#pragma unroll
        for (int i = 0; i < 8; ++i) r[i] = __builtin_nontemporal_load(s + (long)(k0 + kk + 8 * i) * N + n0 + nn); }
    while (t < tot) {
        const int b = t / per, l = t - b * per, k0 = (l / tn) * 64, n0 = (l % tn) * 64;
        bf16_t* d = dst + (long)b * dstB;
#pragma unroll
        for (int i = 0; i < 8; ++i) tile[(kk + 8 * i) * 65 + nn] = r[i];
        __syncthreads();
        const int t2 = t + nblk;
        if (t2 < tot) { const int b2 = t2 / per, l2 = t2 - b2 * per, k2 = (l2 / tn) * 64, n2 = (l2 % tn) * 64; const float* s2 = src + (long)b2 * K * N;
#pragma unroll
            for (int i = 0; i < 8; ++i) r[i] = __builtin_nontemporal_load(s2 + (long)(k2 + kk + 8 * i) * N + n2 + nn); }
#pragma unroll
        for (int i = 0; i < 8; ++i) { const int n = kk + 8 * i, k = nn; d[(long)(n0 + n) * K + k0 + k] = f2bf(tile[k * 65 + n] * scale); }
        __syncthreads();
        t = t2;
    }
}

__device__ __forceinline__ float wave_sum(float v) {
#pragma unroll
    for (int o = 32; o > 0; o >>= 1) v += __shfl_xor(v, o, 64);
    return v;
}
__device__ __forceinline__ float wave_max(float v) {
#pragma unroll
    for (int o = 32; o > 0; o >>= 1) v = fmaxf(v, __shfl_xor(v, o, 64));
    return v;
}

__device__ void rms_phase(const int bid, const int nblk, long g0, long nrows, const float* __restrict__ src0, const float* __restrict__ src1, long split, const float* __restrict__ gain,
                          bf16_t* __restrict__ dst, bf16_t* __restrict__ cpy) {
    const int wid = tid_() >> 6, lane = tid_() & 63;
    f32x4 gv[4];
#pragma unroll
    for (int i = 0; i < 4; ++i) gv[i] = *(const f32x4*)(gain + i * 256 + lane * 4);
    const long stride = (long)nblk * 8;
    for (long r = (long)bid * 8 + wid; r < nrows; r += 2 * stride) {
        const long rr[2] = {r, r + stride};
        f32x4 v[2][4];
#pragma unroll
        for (int q = 0; q < 2; ++q) if (rr[q] < nrows) {
            const long gr = g0 + rr[q];
            const float* s = gr < split ? src0 + gr * DM : src1 + (gr - split) * DM;
#pragma unroll
            for (int i = 0; i < 4; ++i) v[q][i] = __builtin_nontemporal_load((const f32x4*)(s + i * 256 + lane * 4));
        }
#pragma unroll
        for (int q = 0; q < 2; ++q) if (rr[q] < nrows) {
            float ss = 0.f;
#pragma unroll
            for (int i = 0; i < 4; ++i) ss += v[q][i][0] * v[q][i][0] + v[q][i][1] * v[q][i][1] + v[q][i][2] * v[q][i][2] + v[q][i][3] * v[q][i][3];
            ss = wave_sum(ss);
            const float rs = rsqrtf(ss * (1.0f / DM) + 1e-6f);
#pragma unroll
            for (int i = 0; i < 4; ++i) {
                u32x2 w; w.x = cvt_pk_bf16(v[q][i][0] * rs * gv[i][0], v[q][i][1] * rs * gv[i][1]); w.y = cvt_pk_bf16(v[q][i][2] * rs * gv[i][2], v[q][i][3] * rs * gv[i][3]);
                *(u32x2*)(dst + rr[q] * DM + i * 256 + lane * 4) = w;
                if (cpy) { u32x2 c; c.x = cvt_pk_bf16(v[q][i][0], v[q][i][1]); c.y = cvt_pk_bf16(v[q][i][2], v[q][i][3]); *(u32x2*)(cpy + rr[q] * DM + i * 256 + lane * 4) = c; }
            }
        }
    }
}
__device__ void rms_bf_phase(const int bid, const int nblk, long nrows, const bf16_t* __restrict__ X, const float* __restrict__ gain, bf16_t* __restrict__ dst) {
    const int wid = tid_() >> 6, lane = tid_() & 63;
    f32x4 gv[4];
#pragma unroll
    for (int i = 0; i < 2; ++i) { gv[2 * i] = *(const f32x4*)(gain + i * 512 + lane * 8); gv[2 * i + 1] = *(const f32x4*)(gain + i * 512 + lane * 8 + 4); }
    const long stride = (long)nblk * 8;
    for (long r = (long)bid * 8 + wid; r < nrows; r += 2 * stride) {
        const long rr[2] = {r, r + stride};
        u32x4 v[2][2];
#pragma unroll
        for (int q = 0; q < 2; ++q) if (rr[q] < nrows) {
#pragma unroll
            for (int i = 0; i < 2; ++i) v[q][i] = *(const u32x4*)(X + rr[q] * DM + i * 512 + lane * 8);
        }
#pragma unroll
        for (int q = 0; q < 2; ++q) if (rr[q] < nrows) {
            float f[16]; float ss = 0.f;
#pragma unroll
            for (int i = 0; i < 2; ++i)
#pragma unroll
                for (int k = 0; k < 4; ++k) { f[i * 8 + 2 * k] = bflo(v[q][i][k]); f[i * 8 + 2 * k + 1] = bfhi(v[q][i][k]); }
#pragma unroll
            for (int k = 0; k < 16; ++k) ss += f[k] * f[k];
            ss = wave_sum(ss);
            const float rs = rsqrtf(ss * (1.0f / DM) + 1e-6f);
#pragma unroll
            for (int i = 0; i < 2; ++i) {
                u32x4 w;
                w.x = cvt_pk_bf16(f[i * 8 + 0] * rs * gv[2 * i][0], f[i * 8 + 1] * rs * gv[2 * i][1]); w.y = cvt_pk_bf16(f[i * 8 + 2] * rs * gv[2 * i][2], f[i * 8 + 3] * rs * gv[2 * i][3]);
                w.z = cvt_pk_bf16(f[i * 8 + 4] * rs * gv[2 * i + 1][0], f[i * 8 + 5] * rs * gv[2 * i + 1][1]); w.w = cvt_pk_bf16(f[i * 8 + 6] * rs * gv[2 * i + 1][2], f[i * 8 + 7] * rs * gv[2 * i + 1][3]);
                *(u32x4*)(dst + rr[q] * DM + i * 512 + lane * 8) = w;
            }
        }
    }
}
__device__ void final_norm_phase(const int bid, const int nblk, const bf16_t* __restrict__ X, float* __restrict__ y, long nrows, const float* __restrict__ gain) {
    const int wid = tid_() >> 6, lane = tid_() & 63;
    f32x4 gv[4];
#pragma unroll
    for (int i = 0; i < 2; ++i) { gv[2 * i] = *(const f32x4*)(gain + i * 512 + lane * 8); gv[2 * i + 1] = *(const f32x4*)(gain + i * 512 + lane * 8 + 4); }
    for (long r = (long)bid * 8 + wid; r < nrows; r += (long)nblk * 8) {
        u32x4 v[2];
#pragma unroll
        for (int i = 0; i < 2; ++i) v[i] = *(const u32x4*)(X + r * DM + i * 512 + lane * 8);
        float f[16]; float ss = 0.f;
#pragma unroll
        for (int i = 0; i < 2; ++i)
#pragma unroll
            for (int k = 0; k < 4; ++k) { f[i * 8 + 2 * k] = bflo(v[i][k]); f[i * 8 + 2 * k + 1] = bfhi(v[i][k]); }
#pragma unroll
        for (int k = 0; k < 16; ++k) ss += f[k] * f[k];
        ss = wave_sum(ss);
        const float rs = rsqrtf(ss * (1.0f / DM) + 1e-6f);
#pragma unroll
        for (int i = 0; i < 2; ++i) {
            f32x4 o0, o1;
#pragma unroll
            for (int j = 0; j < 4; ++j) { o0[j] = f[i * 8 + j] * rs * gv[2 * i][j]; o1[j] = f[i * 8 + 4 + j] * rs * gv[2 * i + 1][j]; }
            __builtin_nontemporal_store(o0, (f32x4*)(y + r * DM + i * 512 + lane * 8)); __builtin_nontemporal_store(o1, (f32x4*)(y + r * DM + i * 512 + lane * 8 + 4));
        }
    }
}
__device__ void dft_row1024_job(const int bid, const int nblk, const bf16_t* __restrict__ YT, bf16_t* __restrict__ F, int CB) {
    const int wid = tid_() >> 6, lane = tid_() & 63;
    const int nrow = CB * DM;
    for (int r = bid * 8 + wid; r < nrow; r += nblk * 8) {
        const bf16_t* y = YT + (long)r * (2 * SEQ) + lane * 8;
        float s = 0.f;
#pragma unroll
        for (int i = 0; i < 4; ++i) { const u32x4 w = *(const u32x4*)(y + i * 512);
#pragma unroll
            for (int k = 0; k < 4; ++k) s += bflo(w[k]) - bfhi(w[k]); }
        s = wave_sum(s);
        if (lane == 0) { const int bi = r >> 10, gc = r & 1023; F[((long)bi * SEQ + 1024) * DM + gc] = f2bf(s * 0.022097086912f); }
    }
}
__device__ void softmax_phase(const int bid, const int nblk, const float* __restrict__ S, bf16_t* __restrict__ P, long nrh) {
    const int wid = tid_() >> 6, lane = tid_() & 63;
    for (long r = (long)bid * 8 + wid; r < nrh; r += (long)nblk * 8) {
        f32x4 v = *(const f32x4*)(S + r * 256 + lane * 4);
        float mx = wave_max(fmaxf(fmaxf(v[0], v[1]), fmaxf(v[2], v[3])));
        f32x4 e; for (int j = 0; j < 4; ++j) e[j] = __expf(v[j] - mx);
        const float inv = 1.0f / wave_sum(e[0] + e[1] + e[2] + e[3]);
        u32x2 w; w.x = cvt_pk_bf16(e[0] * inv, e[1] * inv); w.y = cvt_pk_bf16(e[2] * inv, e[3] * inv);
        *(u32x2*)(P + r * 256 + lane * 4) = w;
    }
}
__device__ void ffn_conv_phase(const int bid, const int nblk, bf16_t* __restrict__ GV, long Tc, const float* __restrict__ cw, const float* __restrict__ cb) {
    const long tot = (Tc / 4) * (DFF / 8);
    for (long i = (long)bid * 512 + tid_(); i < tot; i += (long)nblk * 512) {
        const long t4 = i / (DFF / 8); const int f = (int)(i - t4 * (DFF / 8)) * 8; const long t = t4 * 4; const int pos = (int)(t & (SEQ - 1));
        bf16_t* g = GV + t * (2 * DFF) + f;
        const u32x4 z = {0u, 0u, 0u, 0u};
        u32x4 gr[6], vr[4];
        gr[0] = pos > 0 ? *(const u32x4*)(g - 2 * DFF) : z;
#pragma unroll
        for (int q = 0; q < 4; ++q) { gr[q + 1] = *(const u32x4*)(g + (long)q * 2 * DFF); vr[q] = *(const u32x4*)(g + (long)q * 2 * DFF + DFF); }
        gr[5] = pos + 4 < SEQ ? *(const u32x4*)(g + (long)4 * 2 * DFF) : z;
        float w0[8], w1[8], w2[8], bb[8];
#pragma unroll
        for (int j = 0; j < 8; ++j) { w0[j] = cw[f + j]; w1[j] = cw[DFF + f + j]; w2[j] = cw[2 * DFF + f + j]; bb[j] = cb[f + j]; }
#pragma unroll
        for (int q = 0; q < 4; ++q) {
            float o[8];
#pragma unroll
            for (int j = 0; j < 8; ++j) {
                const unsigned a0 = gr[q][j >> 1], a1 = gr[q + 1][j >> 1], a2 = gr[q + 2][j >> 1], av = vr[q][j >> 1];
                const float x0 = (j & 1) ? bfhi(a0) : bflo(a0), x1 = (j & 1) ? bfhi(a1) : bflo(a1), x2 = (j & 1) ? bfhi(a2) : bflo(a2), xv = (j & 1) ? bfhi(av) : bflo(av);
                o[j] = gelu_tanh(x0 * w0[j] + x1 * w1[j] + x2 * w2[j] + bb[j]) * xv;
            }
            u32x4 w; w.x = cvt_pk_bf16(o[0], o[1]); w.y = cvt_pk_bf16(o[2], o[3]); w.z = cvt_pk_bf16(o[4], o[5]); w.w = cvt_pk_bf16(o[6], o[7]);
            *(u32x4*)(g + (long)q * 2 * DFF + DFF) = w;
        }
    }
}
__device__ void ffn_fix_phase(const int bid, const int nblk, bf16_t* __restrict__ H, int nMt, const float* __restrict__ edge, const float* __restrict__ cw) {
    const long edgeN = (long)nMt * 2 * DFF; const long tot = (long)nMt * 2 * (DFF / 4);
    for (long i = (long)bid * 512 + tid_(); i < tot; i += (long)nblk * 512) {
        const int pm = (int)(i / (2 * (DFF / 4))); const int rem = (int)(i - (long)pm * (2 * (DFF / 4))); const int e = rem / (DFF / 4), f = (rem - e * (DFF / 4)) * 4;
        const int sp = pm & 7;
        if ((e == 0 && sp == 0) || (e == 1 && sp == 7)) continue;
        const float* me = edge + ((long)pm * 2 + e) * DFF + f;
        const f32x4 part = *(const f32x4*)(me + edgeN), v = *(const f32x4*)(me + 2 * edgeN);
        const f32x4 gn = e == 0 ? *(const f32x4*)(edge + ((long)(pm - 1) * 2 + 1) * DFF + f) : *(const f32x4*)(edge + ((long)(pm + 1) * 2 + 0) * DFF + f);
        const f32x4 w = *(const f32x4*)(cw + (e == 0 ? 0 : 2 * DFF) + f);
        float o[4];
#pragma unroll
        for (int j = 0; j < 4; ++j) o[j] = gelu_tanh(part[j] + w[j] * gn[j]) * v[j];
        u32x2 ww; ww.x = cvt_pk_bf16(o[0], o[1]); ww.y = cvt_pk_bf16(o[2], o[3]);
        *(u32x2*)(H + ((long)pm * BM + (e == 0 ? 0 : 255)) * DFF + f) = ww;
    }
}
__device__ void lru_conv_phase(const int bid, const int nblk, const bf16_t* __restrict__ U, bf16_t* __restrict__ cbuf, long Tc, const float* __restrict__ cw, const float* __restrict__ cb) {
    const long tot = (Tc / 4) * (DRNN / 8);
    for (long i = (long)bid * 512 + tid_(); i < tot; i += (long)nblk * 512) {
        const long t4 = i / (DRNN / 8); const int f = (int)(i - t4 * (DRNN / 8)) * 8; const long t = t4 * 4; const int pos = (int)(t & (SEQ - 1));
        const bf16_t* g = U + t * (2 * DRNN) + DRNN + f;
        const u32x4 z = {0u, 0u, 0u, 0u};
        u32x4 rr[7];
        rr[0] = pos > 1 ? *(const u32x4*)(g - 4 * DRNN) : z; rr[1] = pos > 0 ? *(const u32x4*)(g - 2 * DRNN) : z;
#pragma unroll
        for (int q = 0; q < 4; ++q) rr[q + 2] = *(const u32x4*)(g + (long)q * 2 * DRNN);
        rr[6] = pos + 4 < SEQ ? *(const u32x4*)(g + (long)4 * 2 * DRNN) : z;
        float w0[8], w1[8], w2[8], w3[8], bb[8];
#pragma unroll
        for (int j = 0; j < 8; ++j) { w0[j] = cw[f + j]; w1[j] = cw[DRNN + f + j]; w2[j] = cw[2 * DRNN + f + j]; w3[j] = cw[3 * DRNN + f + j]; bb[j] = cb[f + j]; }
#pragma unroll
        for (int q = 0; q < 4; ++q) {
            float o[8];
#pragma unroll
            for (int j = 0; j < 8; ++j) {
                const unsigned a0 = rr[q][j >> 1], a1 = rr[q + 1][j >> 1], a2 = rr[q + 2][j >> 1], a3 = rr[q + 3][j >> 1];
                const float x0 = (j & 1) ? bfhi(a0) : bflo(a0), x1 = (j & 1) ? bfhi(a1) : bflo(a1), x2 = (j & 1) ? bfhi(a2) : bflo(a2), x3 = (j & 1) ? bfhi(a3) : bflo(a3);
                o[j] = x0 * w0[j] + x1 * w1[j] + x2 * w2[j] + x3 * w3[j] + bb[j];
            }
            u32x4 w; w.x = cvt_pk_bf16(o[0], o[1]); w.y = cvt_pk_bf16(o[2], o[3]); w.z = cvt_pk_bf16(o[4], o[5]); w.w = cvt_pk_bf16(o[6], o[7]);
            *(u32x4*)(cbuf + (t + q) * DRNN + f) = w;
        }
    }
}
__device__ void scan_phase(const int bid, const int nblk, bf16_t* __restrict__ U, const unsigned* __restrict__ LB, long Tc, int CB, float* sm) {
    const int wid = tid_() >> 6, lane = tid_() & 63;
    const int nitems = CB * (DRNN / 128);
    for (int it = bid; it < nitems; it += nblk) {
        const int bi = it / (DRNN / 128), cgp = it - bi * (DRNN / 128); const int ch = cgp * 128 + lane * 2;
        const long row0 = (long)bi * SEQ + wid * 256;
        const unsigned* lf = LB + row0 * DRNN + ch; const unsigned* lb = lf + Tc * DRNN;
        float Sf0 = 0.f, Sf1 = 0.f, Bf0 = 0.f, Bf1 = 0.f, Sb0 = 0.f, Sb1 = 0.f, Bb0 = 0.f, Bb1 = 0.f;
#pragma unroll 16
        for (int t = 0; t < 256; ++t) {
            const u32x2 w1 = *(const u32x2*)(lf + (long)t * DRNN);
            Bf0 = __expf(bflo(w1.x)) * Bf0 + bfhi(w1.x); Sf0 += bflo(w1.x); Bf1 = __expf(bflo(w1.y)) * Bf1 + bfhi(w1.y); Sf1 += bflo(w1.y);
            const int tb = 255 - t;
            const u32x2 w2 = *(const u32x2*)(lb + (long)tb * DRNN);
            Bb0 = __expf(bflo(w2.x)) * Bb0 + bfhi(w2.x); Sb0 += bflo(w2.x); Bb1 = __expf(bflo(w2.y)) * Bb1 + bfhi(w2.y); Sb1 += bflo(w2.y);
        }
        float* my = sm + (wid * 64 + lane) * 8;
        my[0] = __expf(Sf0); my[1] = Bf0; my[2] = __expf(Sb0); my[3] = Bb0; my[4] = __expf(Sf1); my[5] = Bf1; my[6] = __expf(Sb1); my[7] = Bb1;
        __syncthreads();
        float hf0 = 0.f, hb0 = 0.f, hf1 = 0.f, hb1 = 0.f;
        for (int s = 0; s < wid; ++s) { const float* o = sm + (s * 64 + lane) * 8; hf0 = o[0] * hf0 + o[1]; hf1 = o[4] * hf1 + o[5]; }
        for (int s = 7; s > wid; --s) { const float* o = sm + (s * 64 + lane) * 8; hb0 = o[2] * hb0 + o[3]; hb1 = o[6] * hb1 + o[7]; }
        __syncthreads();
        bf16_t* Ug = U + row0 * (2 * DRNN) + ch;
#pragma unroll 16
        for (int t = 0; t < 256; ++t) {
            const u32x2 w1 = *(const u32x2*)(lf + (long)t * DRNN);
            hf0 = __expf(bflo(w1.x)) * hf0 + bfhi(w1.x); hf1 = __expf(bflo(w1.y)) * hf1 + bfhi(w1.y);
            *(unsigned*)(Ug + (long)t * (2 * DRNN) + DRNN) = cvt_pk_bf16(hf0, hf1);
        }
#pragma unroll 16
        for (int t = 255; t >= 0; --t) {
            const u32x2 w2 = *(const u32x2*)(lb + (long)t * DRNN);
            hb0 = __expf(bflo(w2.x)) * hb0 + bfhi(w2.x); hb1 = __expf(bflo(w2.y)) * hb1 + bfhi(w2.y);
            const unsigned hfw = *(const unsigned*)(Ug + (long)t * (2 * DRNN) + DRNN), gw = *(const unsigned*)(Ug + (long)t * (2 * DRNN));
            *(unsigned*)(Ug + (long)t * (2 * DRNN)) = cvt_pk_bf16((bflo(hfw) + hb0) * bflo(gw), (bfhi(hfw) + hb1) * bfhi(gw));
        }
    }
}

__device__ void lru_fused_phase(const int bid, const int nblk, bf16_t* __restrict__ U, bf16_t* __restrict__ HF, const bf16_t* __restrict__ Wg, const float* __restrict__ cw, const float* __restrict__ cb,
                                const float* __restrict__ b_a, const float* __restrict__ b_i, const float* __restrict__ c8sp, int CB, unsigned char* smem) {
    constexpr int RS = 272;
    const int tid = tid_(), wid = tid >> 6, lane = tid & 63, fr = lane & 15, fq = lane >> 4;
    const int nitems = CB * 10;
    for (int it = bid; it < nitems; it += nblk) {
        const int bi = it / 10, h = it - bi * 10;
        const long rowb = (long)bi * SEQ;
        const int chl = 16 * wid + fr, ch = h * 128 + chl;
        const int sch = h * 128 + 2 * lane;
        float w0[2], w1[2], w2[2], w3[2], wb[2];
#pragma unroll
        for (int q = 0; q < 2; ++q) { w0[q] = cw[sch + q]; w1[q] = cw[DRNN + sch + q]; w2[q] = cw[2 * DRNN + sch + q]; w3[q] = cw[3 * DRNN + sch + q]; wb[q] = cb[sch + q]; }
        const bf16_t* recp = U + rowb * (2 * DRNN) + DRNN + sch;
        for (int e = 0; e < 2; ++e) {
            bf16x8 Bf[2][4];
#pragma unroll
            for (int g = 0; g < 2; ++g)
#pragma unroll
                for (int s = 0; s < 4; ++s) Bf[g][s] = *(const bf16x8*)(Wg + ((long)((e * 10 + h) * 256 + g * 128 + chl)) * 128 + 32 * s + 8 * fq);
            const float ba = b_a[e * DRNN + ch], bi_ = b_i[e * DRNN + ch], sp = c8sp[e * DRNN + ch];
            float hs = 0.f;
            unsigned xr[11];
            {
                const int k = e == 0 ? 0 : 31; const int p0 = 64 * k + 8 * wid - 2;
#pragma unroll
                for (int i = 0; i < 11; ++i) { const int pos = p0 + i; xr[i] = (pos >= 0 && pos < SEQ) ? *(const unsigned*)(recp + (long)pos * (2 * DRNN)) : 0u; }
#pragma unroll
                for (int r = 0; r < 8; ++r) {
                    const float c0 = wb[0] + w0[0] * bflo(xr[r]) + w1[0] * bflo(xr[r + 1]) + w2[0] * bflo(xr[r + 2]) + w3[0] * bflo(xr[r + 3]);
                    const float c1 = wb[1] + w0[1] * bfhi(xr[r]) + w1[1] * bfhi(xr[r + 1]) + w2[1] * bfhi(xr[r + 2]) + w3[1] * bfhi(xr[r + 3]);
                    *(unsigned*)(smem + (8 * wid + r) * RS + lane * 4) = cvt_pk_bf16(c0, c1);
                }
            }
            __syncthreads();
            for (int kk = 0; kk < 32; ++kk) {
                const int k = e == 0 ? kk : 31 - kk;
                unsigned char* buf = smem + (kk & 1) * (64 * RS);
                if (kk + 1 < 32) {
                    const int kn = e == 0 ? kk + 1 : 30 - kk; const int p0 = 64 * kn + 8 * wid - 2;
#pragma unroll
                    for (int i = 0; i < 11; ++i) { const int pos = p0 + i; xr[i] = (pos >= 0 && pos < SEQ) ? *(const unsigned*)(recp + (long)pos * (2 * DRNN)) : 0u; }
                }
#pragma unroll
                for (int rti = 0; rti < 4; ++rti) {
                    const int rt = e == 0 ? rti : 3 - rti;
                    const long grow = rowb + 64 * k + 16 * rt + 4 * fq;
                    unsigned short hfv[4], gtv[4];
                    if (e == 1) {
#pragma unroll
                        for (int j = 0; j < 4; ++j) { hfv[j] = HF[(grow + j) * DRNN + ch]; gtv[j] = U[(grow + j) * (2 * DRNN) + ch]; }
                    }
                    f32x4 za = {0.f, 0.f, 0.f, 0.f}, zi = {0.f, 0.f, 0.f, 0.f};
#pragma unroll
                    for (int s = 0; s < 4; ++s) {
                        const bf16x8 af = *(const bf16x8*)(buf + (16 * rt + fr) * RS + (32 * s + 8 * fq) * 2);
                        za = __builtin_amdgcn_mfma_f32_16x16x32_bf16(af, Bf[0][s], za, 0, 0, 0);
                        zi = __builtin_amdgcn_mfma_f32_16x16x32_bf16(af, Bf[1][s], zi, 0, 0, 0);
                    }
                    float av[4], bv[4];
#pragma unroll
                    for (int j = 0; j < 4; ++j) {
                        const float c = bf2f(*(const unsigned short*)(buf + (16 * rt + 4 * fq + j) * RS + chl * 2));
                        const float r = sigmoidf(za[j] + ba), ig = sigmoidf(zi[j] + bi_);
                        const float la = -sp * r;
                        av[j] = __expf(la);
                        bv[j] = __builtin_sqrtf(fmaxf(1.0f - av[j] * av[j], 0.f)) * ig * c;
                    }
                    float hl[4], pp[4];
                    if (e == 0) { hl[0] = bv[0]; pp[0] = av[0];
#pragma unroll
                        for (int j = 1; j < 4; ++j) { hl[j] = av[j] * hl[j - 1] + bv[j]; pp[j] = av[j] * pp[j - 1]; } }
                    else { hl[3] = bv[3]; pp[3] = av[3];
#pragma unroll
                        for (int j = 2; j >= 0; --j) { hl[j] = av[j] * hl[j + 1] + bv[j]; pp[j] = av[j] * pp[j + 1]; } }
                    const float Ag = e == 0 ? pp[3] : pp[0], Hg = e == 0 ? hl[3] : hl[0];
                    float A4[4], H4[4];
#pragma unroll
                    for (int f = 0; f < 4; ++f) { A4[f] = __shfl(Ag, fr + 16 * f, 64); H4[f] = __shfl(Hg, fr + 16 * f, 64); }
                    float carry, sN;
                    if (e == 0) { const float s0 = hs, s1 = A4[0] * s0 + H4[0], s2 = A4[1] * s1 + H4[1], s3 = A4[2] * s2 + H4[2]; sN = A4[3] * s3 + H4[3];
                        carry = fq == 0 ? s0 : (fq == 1 ? s1 : (fq == 2 ? s2 : s3)); }
                    else { const float t0 = hs, t1 = A4[3] * t0 + H4[3], t2 = A4[2] * t1 + H4[2], t3 = A4[1] * t2 + H4[1]; sN = A4[0] * t3 + H4[0];
                        carry = fq == 3 ? t0 : (fq == 2 ? t1 : (fq == 1 ? t2 : t3)); }
                    hs = sN;
#pragma unroll
                    for (int j = 0; j < 4; ++j) {
                        const float hv = hl[j] + pp[j] * carry;
                        if (e == 0) HF[(grow + j) * DRNN + ch] = f2bf(hv);
                        else U[(grow + j) * (2 * DRNN) + ch] = f2bf((bf2f(hfv[j]) + hv) * bf2f(gtv[j]));
                    }
                }
                if (kk + 1 < 32) {
                    unsigned char* nb = smem + ((kk + 1) & 1) * (64 * RS);
#pragma unroll
                    for (int r = 0; r < 8; ++r) {
                        const float c0 = wb[0] + w0[0] * bflo(xr[r]) + w1[0] * bflo(xr[r + 1]) + w2[0] * bflo(xr[r + 2]) + w3[0] * bflo(xr[r + 3]);
                        const float c1 = wb[1] + w0[1] * bfhi(xr[r]) + w1[1] * bfhi(xr[r + 1]) + w2[1] * bfhi(xr[r + 2]) + w3[1] * bfhi(xr[r + 3]);
                        *(unsigned*)(nb + (8 * wid + r) * RS + lane * 4) = cvt_pk_bf16(c0, c1);
                    }
                }
                __syncthreads();
            }
        }
    }
}

#define XB_TMO      128
#define XB_XCNT(j)  (256  + 64 * (j))
#define XB_XSUB(j)  (1280 + 64 * (j))
#define XB_XGEN(j)  (2304 + 64 * (j))
#define XB_TOP      3328
#define XB_TOPGEN   3392
#define XCD_BAR_WORDS 3456
#define XB_SPIN_CAP (1u << 22)
__device__ __forceinline__ unsigned xb_ld(unsigned* p)              { return __hip_atomic_load(p, __ATOMIC_RELAXED, __HIP_MEMORY_SCOPE_AGENT); }
__device__ __forceinline__ unsigned xb_add(unsigned* p, unsigned v) { return __hip_atomic_fetch_add(p, v, __ATOMIC_RELAXED, __HIP_MEMORY_SCOPE_AGENT); }
__device__ __forceinline__ unsigned xb_xcc_id() { return (unsigned)__builtin_amdgcn_s_getreg((3 << 11) | 20) & 0xFu; }
#define XB_SPIN(cond, bar) do { unsigned _sp = 0; while (cond) { __builtin_amdgcn_s_sleep(1); \
    if ((++_sp & 255u) == 0u) { if (xb_ld(&(bar)[XB_TMO])) break; if (_sp > XB_SPIN_CAP) { atomicAdd(&(bar)[XB_TMO], 1u); break; } } } } while (0)
__device__ __forceinline__ void xcd_barrier_complete(unsigned* bar, unsigned x, unsigned G, unsigned& nloc, unsigned& nx) {
    unsigned sum, cnt, mine, sp = 0u;
    for (;;) {
        sum = 0u; cnt = 0u; mine = 0u;
#pragma unroll
        for (unsigned j = 0; j < 16; ++j) { const unsigned c = xb_ld(&bar[XB_XCNT(j)]); sum += c; cnt += (c > 0u) ? 1u : 0u; mine = (j == x) ? c : mine; }
        if (sum == G) break;
        __builtin_amdgcn_s_sleep(1);
        if ((++sp & 255u) == 0u) { if (xb_ld(&bar[XB_TMO])) break; if (sp > XB_SPIN_CAP) { atomicAdd(&bar[XB_TMO], 1u); break; } }
    }
    nloc = mine > 0u ? mine : 1u; nx = cnt > 0u ? cnt : 1u;
}
__device__ __forceinline__ void xcd_barrier(unsigned* bar, volatile LAS unsigned* st, unsigned G) {
    asm volatile("s_waitcnt vmcnt(0)" ::: "memory");
    __syncthreads();
    if (tid_() == 0) {
        const unsigned x = xb_xcc_id();
        __builtin_amdgcn_s_waitcnt(0);
        unsigned nloc = st[0], nx = st[1];
        if (nloc == 0u) { xcd_barrier_complete(bar, x, G, nloc, nx); st[0] = nloc; st[1] = nx; }
        const unsigned old = xb_add(&bar[XB_XSUB(x)], 1u);
        const unsigned gen = old / nloc;
        if (old + 1u == (gen + 1u) * nloc) {
            __builtin_amdgcn_fence(__ATOMIC_RELEASE, "agent");
            asm volatile("s_waitcnt vmcnt(0)" ::: "memory");
            const unsigned og = xb_add(&bar[XB_TOP], 1u);
            const unsigned tg = og / nx;
            if (og + 1u == (tg + 1u) * nx) xb_add(&bar[XB_TOPGEN], 1u);
            else XB_SPIN(xb_ld(&bar[XB_TOPGEN]) == tg, bar);
            __builtin_amdgcn_fence(__ATOMIC_ACQUIRE, "agent");
            xb_add(&bar[XB_XGEN(x)], 1u);
            asm volatile("s_waitcnt vmcnt(0)" ::: "memory");
        } else {
            XB_SPIN(xb_ld(&bar[XB_XGEN(x)]) == gen, bar);
            __builtin_amdgcn_fence(__ATOMIC_ACQUIRE, "agent");
            asm volatile("s_waitcnt vmcnt(0)" ::: "memory");
        }
    }
    __syncthreads();
}

__device__ void prologue_phase(const int bid, const int nblk, const int z0, const Params& p, float* smf) {
    transpose_job(bid, nblk, smf, p.in[5 + z0], p.wp[WP_FNET + z0], DM, DM, 1, 0, 1.0f);
    transpose_job(bid, nblk, smf, p.in[7 + z0], p.wp[WP_IN + z0], DM, 2 * DRNN, 1, 0, 1.0f);
    transpose_job(bid, nblk, smf, p.in[15 + z0], p.wp[WP_LOUT + z0], DRNN, DM, 1, 0, 1.0f);
    transpose_job(bid, nblk, smf, p.in[18 + z0], p.wp[WP_Q + z0], DM, DM, 2, (long)DM * DM, 0.0625f);
    transpose_job(bid, nblk, smf, p.in[19 + z0], p.wp[WP_KV + z0], DM, 2 * DM, 2, (long)2 * DM * DM, 1.0f);
    transpose_job(bid, nblk, smf, p.in[20 + z0], p.wp[WP_O + z0], DM, DM, 2, (long)DM * DM, 1.0f);
    transpose_job(bid, nblk, smf, p.in[22 + z0], p.wp[WP_UP + z0], DM, 2 * DFF, 2, (long)2 * DFF * DM, 1.0f);
    transpose_job(bid, nblk, smf, p.in[25 + z0], p.wp[WP_DOWN + z0], DFF, DM, 2, (long)DFF * DM, 1.0f);
    transpose_job(bid, nblk, smf, p.in[10 + z0], p.wp[WP_GATE + z0], 128, 128, 20, 256 * 128, 1.0f);
    transpose_job(bid, nblk, smf, p.in[12 + z0], p.wp[WP_GATE + z0] + 128 * 128, 128, 128, 20, 256 * 128, 1.0f);
    const long gtid = (long)bid * 512 + tid_(), gth = (long)nblk * 512;
    for (long i = gtid; i < 512 * 256; i += gth) { const int m = (int)(i >> 8), c = (int)(i & 255), cp = m >> 1; const int idx = (c * cp) & 255;
        const float ang = (float)idx * (1.0f / 128.0f); p.wp[WP_CS + z0][i] = f2bf(((m & 1) ? sinpif(ang) : cospif(ang)) * 0.0625f); }
    for (long i = gtid; i < (long)SEQ * 2 * SEQ; i += gth) { const int sp = (int)(i >> 12), k = (int)(i & 4095), s = k & 2047; const int idx = (sp * s) & 2047;
        const float ang = (float)idx * (1.0f / 1024.0f); p.wp[WP_DFTA + z0][i] = f2bf((k < SEQ ? cospif(ang) : -sinpif(ang)) * 0.022097086912f); }
    for (long i = gtid; i < 2 * DRNN; i += gth) p.c8sp[i] = 8.0f * log1pf(__expf(-p.in[14 + z0][i]));
    for (int l = 0; l < 2; ++l)
        rms_phase(bid, nblk, 0, (long)NB * NMEM, p.in[2 + z0], p.in[3 + z0], (long)16 * NMEM, p.in[17 + z0] + l * DM, p.wp[WP_MN + z0] + (long)l * NB * NMEM * DM, nullptr);
}

constexpr int NSTEP = 27;
__global__ __launch_bounds__(512, 2) void mega(Params p) {
    extern __shared__ __attribute__((aligned(16))) unsigned char shm[];
    cg::grid_group grid = cg::this_grid();
    volatile LAS unsigned* st = (volatile LAS unsigned*)((LAS unsigned char*)shm + (LDS_BYTES - 16));
    if (threadIdx.x == 0) { st[0] = 0u; st[1] = 0u; (void)xb_add(&p.bar[XB_XCNT(xb_xcc_id())], 1u); }
    grid.sync();
    const int total = 3 + p.nch * NSTEP;
    for (int pc = 0; pc < total; ++pc) {
        int z0; asm volatile("s_mov_b32 %0, 0" : "=s"(z0));
        const int bid = blockIdx.x + z0, nblk = gridDim.x + z0;
        int kind, arg, chunk;
        if (pc < 3) { kind = pc == 0 ? K_PROLOGUE : K_GEMM; arg = 17 + pc; chunk = 0; }
        else { const int q = pc - 3; chunk = q / NSTEP; const int s = q - chunk * NSTEP; kind = p.kind[s]; arg = p.arg[s]; }
        if (kind == K_GEMM) {
            if (arg == 1 && pc >= 3) dft_row1024_job(bid, nblk, (const bf16_t*)(p.R1 + z0), p.wp[WP_R0 + z0], p.CB + z0);
            gemm_phase(bid, nblk, (LAS unsigned char*)shm, arg, chunk, p);
        } else {
            const int CB = p.CB + z0; const long Tc = (long)CB * SEQ; const long r0 = (long)chunk * Tc;
            float* smf = (float*)shm;
            unsigned char* R1 = p.R1 + z0; bf16_t* R0 = p.wp[WP_R0 + z0]; float* out = p.out + z0;
#define IN(k) p.in[(k) + z0]
            switch (kind) {
                case K_PROLOGUE: prologue_phase(bid, nblk, z0, p, smf); break;
                case K_RMS_IN: rms_phase(bid, nblk, r0, Tc, IN(0), IN(1), (long)16 * SEQ, IN(4), R0, p.xr + z0); break;
                case K_RMS_MIX1: rms_bf_phase(bid, nblk, Tc, p.xr + z0, IN(4) + DM, R0); break;
                case K_RMS_XA: rms_bf_phase(bid, nblk, Tc, p.xr + z0, IN(16) + arg * DM, R0); break;
                case K_RMS_FFN: rms_bf_phase(bid, nblk, Tc, p.xr + z0, IN(21) + arg * DM, R0); break;
                case K_SOFTMAX: softmax_phase(bid, nblk, (const float*)(R1 + Tc * 2048), (bf16_t*)R1, Tc * 4); break;
                case K_FFNFIX: ffn_fix_phase(bid, nblk, (bf16_t*)R1, (int)(Tc / BM), p.edge + z0, IN(23) + arg * 3 * DFF); break;
                case K_FFNCONV: ffn_conv_phase(bid, nblk, (bf16_t*)R1, Tc, IN(23) + arg * 3 * DFF, IN(24) + arg * DFF); break;
                case K_LRUCONV: lru_conv_phase(bid, nblk, (const bf16_t*)R1, (bf16_t*)(R1 + Tc * 5120), Tc, IN(8), IN(9)); break;
                case K_LRU: lru_fused_phase(bid, nblk, (bf16_t*)R1, (bf16_t*)(R1 + Tc * 5120), p.wp[WP_GATE + z0], IN(8), IN(9), IN(11), IN(13), p.c8sp + z0, CB, (unsigned char*)shm); break;
                case K_SCAN: scan_phase(bid, nblk, (bf16_t*)R1, (const unsigned*)(R1 + Tc * 7680), Tc, CB, smf); break;
                case K_FINAL: final_norm_phase(bid, nblk, p.xr + z0, out + r0 * DM, Tc, IN(26)); break;
                default: break;
            }
#undef IN
        }
        if (pc != 1 && pc != total - 1) xcd_barrier(p.bar + z0, st, (unsigned)nblk);
    }
}

static GemmDesc mkdesc(const void* A, const void* B, void* C, const float* bias, int nM, int nN, int nZ, int zdiv,
                       long aZ1, long aZ2, long bZ1, long bZ2, long aTile, long bTile, long cZ1, long cZ2, int csz,
                       long aCh, long bCh, long cCh, int K, int lda, int ldb, int ldc, int epi, int gelu_pn) {
    GemmDesc d{};
    d.A = (const char*)A; d.B = (const char*)B; d.C = (char*)C; d.bias = bias;
    d.aZ1 = (unsigned)(aZ1 * 2); d.aZ2 = (unsigned)(aZ2 * 2); d.bZ1 = (unsigned)(bZ1 * 2); d.bZ2 = (unsigned)(bZ2 * 2); d.aTile = (unsigned)(aTile * 2); d.bTile = (unsigned)(bTile * 2);
    d.cZ1 = (unsigned)(cZ1 * csz); d.cZ2 = (unsigned)(cZ2 * csz);
    d.aCh = (unsigned)(aCh * 2); d.bCh = (unsigned)(bCh * 2); d.cCh = (unsigned)(cCh * csz);
    d.bhalf = 128;
    { auto magic = [](unsigned dd) { return (unsigned)((0x100000000ull / dd) + 1ull); };
      d.mper = magic((unsigned)(nM * nN)); d.mnig = magic((unsigned)(8 * nN)); d.mgsz = magic((unsigned)(nM < 8 ? nM : 8)); d.mzdiv = zdiv > 1 ? magic((unsigned)zdiv) : 0u; d.padm = 0u; }
    d.nM = nM; d.nN = nN; d.nZ = nZ; d.zdiv = zdiv; d.K = K; d.lda = lda; d.ldb = ldb; d.ldc = ldc; d.epi = epi; d.gelu_pn = gelu_pn;
    return d;
}

extern "C" void kernel_launch(void* const* d_in, const int* in_sizes, int n_in, void* d_out, int out_size, void* d_ws, size_t ws_size, hipStream_t stream) {
    static int grid = 0;
    if (grid == 0) {
        int dev = 0, cus = 0, per_cu = 0;
        (void)hipGetDevice(&dev);
        (void)hipDeviceGetAttribute(&cus, hipDeviceAttributeMultiprocessorCount, dev);
        if (hipFuncSetAttribute((const void*)mega, hipFuncAttributeMaxDynamicSharedMemorySize, LDS_BYTES) != hipSuccess) { fprintf(stderr, "hipFuncSetAttribute failed\n"); }
        if (hipOccupancyMaxActiveBlocksPerMultiprocessor(&per_cu, (const void*)mega, 512, LDS_BYTES) != hipSuccess || per_cu < 1) per_cu = 1;
        (void)hipGetLastError();
        grid = cus * per_cu;
    }
    Params p{};
    for (int i = 0; i < 27; ++i) p.in[i] = (const float*)d_in[i];
    p.out = (float*)d_out;
    size_t off = 0; unsigned char* ws = (unsigned char*)d_ws;
    auto take = [&](size_t bytes) { unsigned char* r = ws + off; off += (bytes + 255) & ~(size_t)255; return r; };
    p.wp[WP_FNET] = (bf16_t*)take((size_t)DM * DM * 2);
    p.wp[WP_IN] = (bf16_t*)take((size_t)2 * DRNN * DM * 2);
    p.wp[WP_GATE] = (bf16_t*)take((size_t)20 * 256 * 128 * 2);
    p.wp[WP_LOUT] = (bf16_t*)take((size_t)DM * DRNN * 2);
    p.wp[WP_Q] = (bf16_t*)take((size_t)2 * DM * DM * 2);
    p.wp[WP_KV] = (bf16_t*)take((size_t)2 * 2 * DM * DM * 2);
    p.wp[WP_O] = (bf16_t*)take((size_t)2 * DM * DM * 2);
    p.wp[WP_UP] = (bf16_t*)take((size_t)2 * 2 * DFF * DM * 2);
    p.wp[WP_DOWN] = (bf16_t*)take((size_t)2 * DM * DFF * 2);
    p.wp[WP_CS] = (bf16_t*)take((size_t)512 * 256 * 2);
    p.wp[WP_DFTA] = (bf16_t*)take((size_t)SEQ * 2 * SEQ * 2);
    p.c8sp = (float*)take((size_t)2 * DRNN * 4);
    p.bar = (unsigned*)take((size_t)XCD_BAR_WORDS * 4);
    p.wp[WP_MN] = (bf16_t*)take((size_t)2 * NB * NMEM * DM * 2);
    bf16_t* Kmat = (bf16_t*)take((size_t)2 * NB * NMEM * DM * 2);
    bf16_t* VT = (bf16_t*)take((size_t)2 * NB * NMEM * DM * 2);
    const int cands[7] = {48, 24, 16, 8, 4, 2, 1};
    int CB = 1;
    for (int i = 0; i < 7; ++i) { const size_t need = off + (size_t)cands[i] * SEQ * (2048 + 7680 + 544 + 2048) + 8192; if (need <= ws_size) { CB = cands[i]; break; } }
    p.CB = CB; p.nch = NB / CB;
    const long Tc = (long)CB * SEQ; const int nMt = (int)(Tc / BM);
    p.wp[WP_R0] = (bf16_t*)take((size_t)Tc * 2048);
    p.R1 = take((size_t)Tc * 7680);
    p.edge = (float*)take((size_t)3 * nMt * 2 * DFF * 4);
    p.xr = (bf16_t*)take((size_t)Tc * 2048);
    bf16_t* XR = p.xr;
    bf16_t* R0 = p.wp[WP_R0]; unsigned char* R1 = p.R1;
    bf16_t* YT = (bf16_t*)R1; bf16_t* Q = (bf16_t*)R1; bf16_t* Pb = (bf16_t*)(R1 + Tc * 2048); bf16_t* GV = (bf16_t*)R1;
    bf16_t* U = (bf16_t*)R1; bf16_t* cbuf = (bf16_t*)(R1 + Tc * 5120); bf16_t* LA = (bf16_t*)(R1 + Tc * 7680);
    float* out = p.out;
    const long MD = (long)NMEM * DM, SD = (long)SEQ * DM;
    p.g[0] = mkdesc(p.wp[WP_CS], R0, YT, nullptr, 2, 8, CB * 4, 4, 0, 0, SD, 256, 256 * 256, 256 * DM, (long)4 * 512 * SEQ, (long)512 * SEQ, 2, 0, 0, 0, 256, 256, DM, SEQ, E_BF16, 0);
    p.g[1] = mkdesc(p.wp[WP_DFTA], YT, R0, nullptr, 4, 4, CB, 1, 0, 0, (long)DM * 2 * SEQ, 0, (long)256 * 2 * SEQ, (long)256 * 2 * SEQ, SD, 0, 2, 0, 0, 0, 2 * SEQ, 2 * SEQ, 2 * SEQ, DM, E_DFT, 0);
    p.g[2] = mkdesc(R0, p.wp[WP_FNET], XR, p.in[6], nMt, 4, 1, 1, 0, 0, 0, 0, 256 * DM, 256 * DM, 0, 0, 2, 0, 0, 0, DM, DM, DM, DM, E_RESID, 0);
    for (int l = 0; l < 2; ++l) {
        const int b = 3 + l * 6;
        p.g[b + 0] = mkdesc(R0, p.wp[WP_Q] + (long)l * DM * DM, Q, nullptr, nMt, 4, 1, 1, 0, 0, 0, 0, 256 * DM, 256 * DM, 0, 0, 2, 0, 0, 0, DM, DM, DM, DM, E_BF16, 0);
        p.g[b + 1] = mkdesc(Q, Kmat + (long)l * NB * MD, Pb, nullptr, 8, 1, CB * 4, 4, SD, 256, MD, 256, 256 * DM, 0, SD, 256, 2, 0, (long)CB * MD, 0, 256, DM, DM, DM, E_SOFTMAX, 0);
        p.g[b + 2] = mkdesc(Pb, VT + (long)l * NB * MD, R0, nullptr, 8, 1, CB * 4, 4, SD, 256, MD, (long)256 * NMEM, 256 * DM, 0, SD, 256, 2, 0, (long)CB * MD, 0, 256, DM, NMEM, DM, E_BF16, 0);
        p.g[b + 3] = mkdesc(R0, p.wp[WP_O] + (long)l * DM * DM, XR, nullptr, nMt, 4, 1, 1, 0, 0, 0, 0, 256 * DM, 256 * DM, 0, 0, 2, 0, 0, 0, DM, DM, DM, DM, E_RESID, 0);
        p.g[b + 4] = mkdesc(R0, p.wp[WP_UP] + (long)l * 2 * DFF * DM, GV, nullptr, nMt, 22, 1, 1, 0, 0, 0, 0, 256 * DM, 128 * DM, 0, 0, 2, 0, 0, 0, DM, DM, DM, DFF, E_FFN, l);
        p.g[b + 4].bhalf = DFF;
        p.g[b + 5] = mkdesc(GV, p.wp[WP_DOWN] + (long)l * DM * DFF, XR, nullptr, nMt, 4, 1, 1, 0, 0, 0, 0, (long)256 * DFF, (long)256 * DFF, 0, 0, 2, 0, 0, 0, DFF, DFF, DFF, DM, E_RESID, 0);
    }
    p.g[15] = mkdesc(R0, p.wp[WP_IN], U, nullptr, nMt, 10, 1, 1, 0, 0, 0, 0, 256 * DM, 256 * DM, 0, 0, 2, 0, 0, 0, DM, DM, DM, 2 * DRNN, E_BF16, 5);
    p.g[16] = mkdesc(cbuf, p.wp[WP_GATE], LA, nullptr, nMt, 1, 20, 10, 0, 128, (long)10 * 256 * 128, (long)256 * 128, (long)256 * DRNN, 0, 0, 0, 2, 0, 0, 0, 128, DRNN, 128, DRNN, E_GATE, 0);
    p.g[17] = mkdesc(U, p.wp[WP_LOUT], XR, nullptr, nMt, 4, 1, 1, 0, 0, 0, 0, (long)256 * 2 * DRNN, (long)256 * DRNN, 0, 0, 2, 0, 0, 0, DRNN, 2 * DRNN, DRNN, DM, E_RESID, 0);
    p.g[18] = mkdesc(p.wp[WP_MN], p.wp[WP_KV], Kmat, nullptr, NB, 4, 2, 1, (long)NB * MD, 0, (long)2 * DM * DM, 0, 256 * DM, 256 * DM, (long)NB * MD, 0, 2, 0, 0, 0, DM, DM, DM, DM, E_BF16, 0);
    p.g[19] = mkdesc(p.wp[WP_KV] + (long)DM * DM, p.wp[WP_MN], VT, nullptr, 4, 1, 2 * NB, NB, (long)2 * DM * DM, 0, (long)NB * MD, MD, 256 * DM, 0, (long)NB * MD, MD, 2, 0, 0, 0, DM, DM, DM, NMEM, E_BF16, 0);
    const unsigned char kinds[NSTEP] = {K_RMS_IN, K_GEMM, K_GEMM, K_GEMM, K_RMS_XA, K_GEMM, K_GEMM, K_GEMM, K_GEMM, K_RMS_FFN, K_GEMM, K_FFNFIX, K_GEMM,
                                         K_RMS_MIX1, K_GEMM, K_LRU, K_GEMM, K_RMS_XA, K_GEMM, K_GEMM, K_GEMM, K_GEMM, K_RMS_FFN, K_GEMM, K_FFNFIX, K_GEMM, K_FINAL};
    const unsigned char args_[NSTEP] = {0, 0, 1, 2, 0, 3, 4, 5, 6, 0, 7, 0, 8,
                                         0, 15, 0, 17, 1, 9, 10, 11, 12, 1, 13, 1, 14, 0};
    for (int i = 0; i < NSTEP; ++i) { p.kind[i] = kinds[i]; p.arg[i] = args_[i]; }
    (void)hipMemsetAsync(p.bar, 0, (size_t)XCD_BAR_WORDS * 4, stream);
    void* args[] = {&p};
    hipError_t e = hipLaunchCooperativeKernel((const void*)mega, dim3(grid), dim3(512), args, LDS_BYTES, stream);
    if (e != hipSuccess) fprintf(stderr, "cooperative launch failed: %s (grid %d)\n", hipGetErrorString(e), grid);
}
```

```cpp
#include <hip/hip_runtime.h>
#include <hip/hip_cooperative_groups.h>
#include <cstdio>
namespace cg = cooperative_groups;

#define LAS __attribute__((address_space(3)))
typedef unsigned short bf16_t;
typedef short bf16x8 __attribute__((ext_vector_type(8)));
typedef float f32x4 __attribute__((ext_vector_type(4)));
typedef unsigned u32x4 __attribute__((ext_vector_type(4)));
typedef unsigned u32x2 __attribute__((ext_vector_type(2)));

constexpr int BM = 256, BK = 64, HALF = 128, HTB = HALF * BK * 2, STAGE_BYTES = 8 * HTB;
constexpr int LDS_BYTES = STAGE_BYTES + 8192;
constexpr int NB = 48, SEQ = 2048, DM = 1024, NMEM = 256, DRNN = 1280, DFF = 2816;

__device__ __forceinline__ int lds_byte(int r, int c) { const int st = (r >> 4) * 2 + (c >> 5), rr = r & 15, cc = c & 31, ob = rr * 64 + cc * 2; return st * 1024 + (ob ^ (((ob >> 9) & 1) << 5)); }
__device__ __forceinline__ void stage_rc(int b, int& R, int& C) { const int st = b / 1024, sb = b % 1024, swz = sb ^ (((sb >> 9) & 1) << 5); R = (st >> 1) * 16 + swz / 64; C = (st & 1) * 32 + (swz % 64) / 2; }
__device__ __forceinline__ int perm32(int rho) { const int n = rho >> 4, i = rho & 15; return 8 * (i >> 2) + 4 * n + (i & 3); }
__device__ __forceinline__ unsigned cvt_pk_bf16(float lo, float hi) { unsigned r; asm volatile("v_cvt_pk_bf16_f32 %0, %1, %2" : "=v"(r) : "v"(lo), "v"(hi)); return r; }
__device__ __forceinline__ bf16_t f2bf(float f) { unsigned u = __float_as_uint(f); u += 0x7FFFu + ((u >> 16) & 1u); return (bf16_t)(u >> 16); }
__device__ __forceinline__ float bf2f(bf16_t b) { return __uint_as_float(((unsigned)b) << 16); }
__device__ __forceinline__ float bflo(unsigned w) { return __uint_as_float(w << 16); }
__device__ __forceinline__ float bfhi(unsigned w) { return __uint_as_float(w & 0xffff0000u); }
__device__ __forceinline__ float gelu_tanh(float x) { const float u = 1.5957691216f * (x + 0.044715f * x * x * x); return x * __builtin_amdgcn_rcpf(1.0f + __expf(-u)); }
typedef float f32x2 __attribute__((ext_vector_type(2)));
__device__ __forceinline__ f32x2 gelu_tanh2(f32x2 x) {
    const f32x2 t = x * x;
    const f32x2 w = x * (t * (-0.10294324f) + (-2.3022082f));
    f32x2 e; e.x = __builtin_amdgcn_exp2f(w.x); e.y = __builtin_amdgcn_exp2f(w.y);
    const f32x2 d = e + 1.0f;
    f32x2 r; r.x = __builtin_amdgcn_rcpf(d.x); r.y = __builtin_amdgcn_rcpf(d.y);
    return x * r;
}
__device__ __forceinline__ int tid_() { int t = threadIdx.x; asm volatile("" : "+v"(t)); return t; }
__device__ __forceinline__ float sigmoidf(float z) { return __builtin_amdgcn_rcpf(1.0f + __expf(-z)); }


struct GemmDesc {
    const char* A; const char* B; char* C; const float* bias;
    unsigned aZ1, aZ2, bZ1, bZ2, aTile, bTile, cZ1, cZ2;
    unsigned aCh, bCh, cCh;
    int nM, nN, nZ, zdiv, K, lda, ldb, ldc, epi, gelu_pn, bhalf;
    unsigned mper, mnig, mgsz, mzdiv, padm;
};
struct Params {
    const float* in[27];
    float* out;
    bf16_t* wp[14];
    unsigned char* R1;
    float* c8sp;
    bf16_t* xr;
    float* edge;
    unsigned* bar;
    int CB, nch;
    unsigned char kind[32]; unsigned char arg[32];
    GemmDesc g[20];
};
enum { WP_FNET = 0, WP_IN, WP_GATE, WP_LOUT, WP_Q, WP_KV, WP_O, WP_UP, WP_DOWN, WP_CS, WP_DFTA, WP_MN, WP_R0, WP_PAD };
enum { K_GEMM = 0, K_PROLOGUE, K_RMS_IN, K_RMS_XA, K_RMS_FFN, K_RMS_MIX1, K_SOFTMAX, K_FFNCONV, K_FFNFIX, K_LRU, K_LRUCONV, K_SCAN, K_FINAL };
enum { E_BF16 = 0, E_F32, E_RESID, E_GATE, E_SOFTMAX, E_FFN, E_DFT };

struct Unit { const char* A; const char* B; int pm, pn, z1, z2; };

__device__ __forceinline__ void epi_bf16(const f32x4 (&acc)[2][2][4][2], const Unit& u, char* Cb, unsigned cZ1, unsigned cZ2, int ldc, int gelu_pn, int wr, int wc, int fr, int fq) {
    bf16_t* base = (bf16_t*)(Cb + (size_t)u.z1 * cZ1 + (size_t)u.z2 * cZ2) + (long)(u.pm * BM + wr * 64 + fr) * ldc + u.pn * BM + wc * 32 + 8 * fq;
    const bool g = u.pn < gelu_pn;
#pragma unroll
    for (int ai = 0; ai < 2; ++ai)
#pragma unroll
        for (int m = 0; m < 4; ++m) { bf16_t* rowp = base + (long)(ai * HALF + m * 16) * ldc;
#pragma unroll
            for (int bj = 0; bj < 2; ++bj) { f32x4 v0 = acc[ai][bj][m][0], v1 = acc[ai][bj][m][1];
                if (g) {
                    const f32x2 a = gelu_tanh2((f32x2){v0[0], v0[1]}), b = gelu_tanh2((f32x2){v0[2], v0[3]}), c = gelu_tanh2((f32x2){v1[0], v1[1]}), d = gelu_tanh2((f32x2){v1[2], v1[3]});
                    v0 = (f32x4){a.x, a.y, b.x, b.y}; v1 = (f32x4){c.x, c.y, d.x, d.y}; }
                u32x4 w; w.x = cvt_pk_bf16(v0[0], v0[1]); w.y = cvt_pk_bf16(v0[2], v0[3]); w.z = cvt_pk_bf16(v1[0], v1[1]); w.w = cvt_pk_bf16(v1[2], v1[3]);
                *(u32x4*)(rowp + bj * HALF) = w; } }
}
__device__ __forceinline__ void epi_f32(const f32x4 (&acc)[2][2][4][2], const Unit& u, char* Cb, unsigned cZ1, unsigned cZ2, int ldc, int wr, int wc, int fr, int fq) {
    float* base = (float*)(Cb + (size_t)u.z1 * cZ1 + (size_t)u.z2 * cZ2) + (long)(u.pm * BM + wr * 64 + fr) * ldc + u.pn * BM + wc * 32 + 4 * fq;
#pragma unroll
    for (int ai = 0; ai < 2; ++ai)
#pragma unroll
        for (int m = 0; m < 4; ++m) { float* rowp = base + (long)(ai * HALF + m * 16) * ldc;
#pragma unroll
            for (int bj = 0; bj < 2; ++bj)
#pragma unroll
                for (int n = 0; n < 2; ++n) *(f32x4*)(rowp + bj * HALF + n * 16) = acc[ai][bj][m][n]; }
}
__device__ __forceinline__ void epi_resid(const f32x4 (&acc)[2][2][4][2], const Unit& u, char* Cb, int ldc, const float* bias, int wr, int wc, int fr, int fq) {
    const int col0 = u.pn * BM + wc * 32 + 8 * fq;
    bf16_t* base = (bf16_t*)Cb + (long)(u.pm * BM + wr * 64 + fr) * ldc + col0;
#pragma unroll
    for (int bj = 0; bj < 2; ++bj) {
        const f32x4 b0 = bias ? *(const f32x4*)(bias + col0 + bj * HALF) : (f32x4){0.f, 0.f, 0.f, 0.f};
        const f32x4 b1 = bias ? *(const f32x4*)(bias + col0 + bj * HALF + 4) : (f32x4){0.f, 0.f, 0.f, 0.f};
#pragma unroll
        for (int ai = 0; ai < 2; ++ai)
#pragma unroll
            for (int m = 0; m < 4; ++m) { u32x4* q = (u32x4*)(base + (long)(ai * HALF + m * 16) * ldc + bj * HALF);
                const u32x4 x = *q; const f32x4 a0 = acc[ai][bj][m][0], a1 = acc[ai][bj][m][1];
                u32x4 w;
                w.x = cvt_pk_bf16(bflo(x.x) + a0[0] + b0[0], bfhi(x.x) + a0[1] + b0[1]); w.y = cvt_pk_bf16(bflo(x.y) + a0[2] + b0[2], bfhi(x.y) + a0[3] + b0[3]);
                w.z = cvt_pk_bf16(bflo(x.z) + a1[0] + b1[0], bfhi(x.z) + a1[1] + b1[1]); w.w = cvt_pk_bf16(bflo(x.w) + a1[2] + b1[2], bfhi(x.w) + a1[3] + b1[3]);
                *q = w; } }
}

__device__ __forceinline__ void epi_softmax(const f32x4 (&acc)[2][2][4][2], const Unit& u, char* Cb, unsigned cZ1, unsigned cZ2, int ldc, LAS float* rs, int wr, int wc, int fr, int fq) {
#pragma unroll
    for (int ai = 0; ai < 2; ++ai)
#pragma unroll
        for (int m = 0; m < 4; ++m) { float s = 0.f;
#pragma unroll
            for (int bj = 0; bj < 2; ++bj)
#pragma unroll
                for (int n = 0; n < 2; ++n)
#pragma unroll
                    for (int j = 0; j < 4; ++j) s += __expf(acc[ai][bj][m][n][j]);
            s += __shfl_xor(s, 16, 64); s += __shfl_xor(s, 32, 64);
            if (fq == 0) rs[((wr * 128 + ai * 64 + m * 16 + fr) << 2) + wc] = s; }
    asm volatile("s_waitcnt lgkmcnt(0)" ::: "memory");
    __builtin_amdgcn_s_barrier();
    __builtin_amdgcn_sched_barrier(0);
    asm volatile("" : "+s"(ldc) :: "memory");
    bf16_t* base = (bf16_t*)(Cb + (size_t)u.z1 * cZ1 + (size_t)u.z2 * cZ2) + (long)(u.pm * BM + wr * 64 + fr) * ldc + u.pn * BM + wc * 32 + 8 * fq;
#pragma unroll
    for (int ai = 0; ai < 2; ++ai)
#pragma unroll
        for (int m = 0; m < 4; ++m) {
            const f32x4 t = *(const LAS f32x4*)&rs[(wr * 128 + ai * 64 + m * 16 + fr) << 2];
            const float lg = __logf(t[0] + t[1] + t[2] + t[3]);
            bf16_t* rowp = base + (long)(ai * HALF + m * 16) * ldc;
#pragma unroll
            for (int bj = 0; bj < 2; ++bj) { f32x4 v0, v1;
#pragma unroll
                for (int j = 0; j < 4; ++j) { v0[j] = __expf(acc[ai][bj][m][0][j] - lg); v1[j] = __expf(acc[ai][bj][m][1][j] - lg); }
                u32x4 w; w.x = cvt_pk_bf16(v0[0], v0[1]); w.y = cvt_pk_bf16(v0[2], v0[3]); w.z = cvt_pk_bf16(v1[0], v1[1]); w.w = cvt_pk_bf16(v1[2], v1[3]);
                *(u32x4*)(rowp + bj * HALF) = w; } }
}

__device__ __forceinline__ float dpp_ror1(float x) { return __builtin_bit_cast(float, __builtin_amdgcn_mov_dpp(__builtin_bit_cast(int, x), 0x121, 0xf, 0xf, true)); }
__device__ __forceinline__ float dpp_rol1(float x) { return __builtin_bit_cast(float, __builtin_amdgcn_mov_dpp(__builtin_bit_cast(int, x), 0x12F, 0xf, 0xf, true)); }
__device__ __forceinline__ void epi_ffn(const f32x4 (&acc)[2][2][4][2], const Unit& u, char* Cb, const float* __restrict__ cw, const float* __restrict__ cb, float* __restrict__ edge, long edgeN,
                                        LAS float* E, int wr, int wc, int fr, int fq) {
    const int cl = wc * 32 + 4 * fq;
#pragma unroll
    for (int ai = 0; ai < 2; ++ai)
#pragma unroll
        for (int n = 0; n < 2; ++n) {
            if (fr == 0)  *(LAS f32x4*)&E[((wr * 2 + ai) * 2 + 0) * 128 + cl + 16 * n] = acc[ai][0][0][n];
            if (fr == 15) *(LAS f32x4*)&E[((wr * 2 + ai) * 2 + 1) * 128 + cl + 16 * n] = acc[ai][0][3][n];
        }
    asm volatile("s_waitcnt lgkmcnt(0)" ::: "memory");
    __builtin_amdgcn_s_barrier();
    __builtin_amdgcn_s_barrier();
    __builtin_amdgcn_sched_barrier(0);
    const int f0 = u.pn * 128 + cl;
    bf16_t* hbase = (bf16_t*)Cb + (long)(u.pm * BM + wr * 64 + fr) * DFF + f0;
#pragma unroll
    for (int n = 0; n < 2; ++n) {
        const f32x4 w0 = *(const f32x4*)(cw + f0 + 16 * n), w1 = *(const f32x4*)(cw + DFF + f0 + 16 * n), w2 = *(const f32x4*)(cw + 2 * DFF + f0 + 16 * n), bb = *(const f32x4*)(cb + f0 + 16 * n);
#pragma unroll
        for (int ai = 0; ai < 2; ++ai) {
            const f32x4 zero = {0.f, 0.f, 0.f, 0.f};
            f32x4 bup, bdn;
            if (wr == 1) bup = *(const LAS f32x4*)&E[((0 * 2 + ai) * 2 + 1) * 128 + cl + 16 * n];
            else if (ai == 1) bup = *(const LAS f32x4*)&E[((1 * 2 + 0) * 2 + 1) * 128 + cl + 16 * n];
            else bup = zero;
            if (wr == 0) bdn = *(const LAS f32x4*)&E[((1 * 2 + ai) * 2 + 0) * 128 + cl + 16 * n];
            else if (ai == 0) bdn = *(const LAS f32x4*)&E[((0 * 2 + 1) * 2 + 0) * 128 + cl + 16 * n];
            else bdn = zero;
            f32x4 r1[4], l1[4];
#pragma unroll
            for (int m = 0; m < 4; ++m)
#pragma unroll
                for (int j = 0; j < 4; ++j) { r1[m][j] = dpp_ror1(acc[ai][0][m][n][j]); l1[m][j] = dpp_rol1(acc[ai][0][m][n][j]); }
#pragma unroll
            for (int m = 0; m < 4; ++m) {
                const f32x4 g = acc[ai][0][m][n], v = acc[ai][1][m][n];
                const f32x4 upw = (m > 0) ? r1[m > 0 ? m - 1 : 0] : bup, dnw = (m < 3) ? l1[m < 3 ? m + 1 : 3] : bdn;
                f32x4 cv; float o[4];
#pragma unroll
                for (int jp = 0; jp < 2; ++jp) {
                    f32x2 up2, dn2;
                    up2.x = (fr == 0) ? upw[2 * jp] : r1[m][2 * jp]; up2.y = (fr == 0) ? upw[2 * jp + 1] : r1[m][2 * jp + 1];
                    dn2.x = (fr == 15) ? dnw[2 * jp] : l1[m][2 * jp]; dn2.y = (fr == 15) ? dnw[2 * jp + 1] : l1[m][2 * jp + 1];
                    const f32x2 g2 = {g[2 * jp], g[2 * jp + 1]}, v2 = {v[2 * jp], v[2 * jp + 1]};
                    const f32x2 w0p = {w0[2 * jp], w0[2 * jp + 1]}, w1p = {w1[2 * jp], w1[2 * jp + 1]}, w2p = {w2[2 * jp], w2[2 * jp + 1]}, bbp = {bb[2 * jp], bb[2 * jp + 1]};
                    const f32x2 c2 = w0p * up2 + (w1p * g2 + (w2p * dn2 + bbp));
                    const f32x2 o2 = gelu_tanh2(c2) * v2;
                    cv[2 * jp] = c2.x; cv[2 * jp + 1] = c2.y; o[2 * jp] = o2.x; o[2 * jp + 1] = o2.y;
                }
                u32x2 w; w.x = cvt_pk_bf16(o[0], o[1]); w.y = cvt_pk_bf16(o[2], o[3]);
                *(u32x2*)(hbase + (long)(ai * HALF + m * 16) * DFF + 16 * n) = w;
                if (ai == 0 && m == 0 && wr == 0 && fr == 0) {
                    float* e0 = edge + ((long)u.pm * 2 + 0) * DFF + f0 + 16 * n;
                    *(f32x4*)e0 = g; *(f32x4*)(e0 + edgeN) = cv; *(f32x4*)(e0 + 2 * edgeN) = v; }
                if (ai == 1 && m == 3 && wr == 1 && fr == 15) {
                    float* e1 = edge + ((long)u.pm * 2 + 1) * DFF + f0 + 16 * n;
                    *(f32x4*)e1 = g; *(f32x4*)(e1 + edgeN) = cv; *(f32x4*)(e1 + 2 * edgeN) = v; }
            }
        }
    }
}

__device__ __forceinline__ void epi_dft(const f32x4 (&acc)[2][2][4][2], const Unit& u, char* Cb, unsigned cZ1, int wr, int wc, int fr, int fq) {
    asm volatile("" : "+v"(fq), "+v"(fr));
    bf16_t* fb = (bf16_t*)(Cb + (size_t)u.z1 * cZ1) + u.pn * BM;
    const int r0 = u.pm * BM + wr * 64 + fr;
#pragma unroll
    for (int ai = 0; ai < 2; ++ai)
#pragma unroll
        for (int m = 0; m < 4; ++m) {
            const int s = r0 + ai * HALF + m * 16;
            bf16_t* rowp = fb + (long)s * DM;
            bf16_t* mir = fb + (long)(SEQ - s) * DM;
#pragma unroll
            for (int bj = 0; bj < 2; ++bj) {
                const int c0 = bj * HALF + wc * 32 + 8 * fq;
                const f32x4 v0 = acc[ai][bj][m][0], v1 = acc[ai][bj][m][1];
                u32x4 w; w.x = cvt_pk_bf16(v0[0], v0[1]); w.y = cvt_pk_bf16(v0[2], v0[3]); w.z = cvt_pk_bf16(v1[0], v1[1]); w.w = cvt_pk_bf16(v1[2], v1[3]);
                *(u32x4*)(rowp + c0) = w;
                if (s != 0) {
                    bf16_t* mg = mir + (248 - c0);
                    mg[1] = (bf16_t)(w.w >> 16);
                    *(unsigned*)(mg + 2) = cvt_pk_bf16(v1[2], v1[1]);
                    u32x2 t; t.x = cvt_pk_bf16(v1[0], v0[3]); t.y = cvt_pk_bf16(v0[2], v0[1]);
                    *(u32x2*)(mg + 4) = t;
                    mir[(256 - c0) & 255] = (bf16_t)(w.x & 0xffffu);
                }
            }
        }
}
__device__ __forceinline__ void epi_gate(const f32x4 (&acc)[2][2][4][2], const Unit& u, const bf16_t* cbuf, unsigned* LB, const float* b_a, const float* b_i, const float* c8sp, long Tc,
                                         int wr, int wc, int fr, int fq) {
    const int e = u.z1, h = u.z2;
#pragma unroll
    for (int n = 0; n < 2; ++n) {
        const int ch = h * 128 + wc * 32 + 8 * fq + 4 * n;
        const f32x4 ba = *(const f32x4*)(b_a + e * DRNN + ch), bi = *(const f32x4*)(b_i + e * DRNN + ch), sp = *(const f32x4*)(c8sp + e * DRNN + ch);
#pragma unroll
        for (int ai = 0; ai < 2; ++ai)
#pragma unroll
            for (int m = 0; m < 4; ++m) {
                const long row = (long)u.pm * BM + ai * HALF + wr * 64 + m * 16 + fr;
                const u32x2 cw = *(const u32x2*)(cbuf + row * DRNN + ch);
                const float cv[4] = {bflo(cw.x), bfhi(cw.x), bflo(cw.y), bfhi(cw.y)};
                u32x4 w;
#pragma unroll
                for (int j = 0; j < 4; ++j) {
                    const float r = sigmoidf(acc[ai][0][m][n][j] + ba[j]);
                    const float ig = sigmoidf(acc[ai][1][m][n][j] + bi[j]);
                    const float la = -sp[j] * r;
                    const float a2 = __expf(2.0f * la);
                    w[j] = cvt_pk_bf16(la, __builtin_sqrtf(fmaxf(1.0f - a2, 0.f)) * ig * cv[j]);
                }
                *(u32x4*)(LB + ((long)e * Tc + row) * DRNN + ch) = w;
            }
    }
}

__device__ __forceinline__ void gemm_phase(const int bid, const int nblk, LAS unsigned char* lds, const int garg, const int chunk, const Params& p) {
    const GemmDesc& d = p.g[garg];
    const int tid = tid_(), wid = __builtin_amdgcn_readfirstlane(tid >> 6), lane = tid & 63, wr = wid >> 2, wc = wid & 3, fr = lane & 15, fq = lane >> 4;
    const int K = d.K, lda = d.lda, ldb = d.ldb, epi = d.epi, nt = K / BK;
    const int nM = d.nM, nN = d.nN, zdiv = d.zdiv, nwg = nM * nN * d.nZ;
    const char* Ab = d.A + (size_t)chunk * d.aCh; const char* Bb = d.B + (size_t)chunk * d.bCh;
    const unsigned aZ1 = d.aZ1, aZ2 = d.aZ2, bZ1 = d.bZ1, bZ2 = d.bZ2, aTile = d.aTile, bTile = d.bTile;
    const unsigned mper = d.mper, mnig = d.mnig, mgsz = d.mgsz, mzdiv = d.mzdiv;
    const int per = nM * nN, nig = 8 * nN, gsz = nM < 8 ? nM : 8, q8 = nwg >> 3, r8 = nwg & 7;
    auto next = [&](int i, Unit& u) -> bool {
        const long L = (long)i * nblk + bid; if (L >= nwg) return false;
        int w = (int)L; { const int xcd = w & 7, off = w >> 3; w = (xcd < r8 ? xcd * (q8 + 1) : r8 * (q8 + 1) + (xcd - r8) * q8) + off; }
        const int z = (int)__umulhi((unsigned)w, mper), loc = w - z * per;
        const int gid = (int)__umulhi((unsigned)loc, mnig), lr = loc - gid * nig;
        const int pn = (int)__umulhi((unsigned)lr, mgsz), pm = gid * 8 + lr - pn * gsz;
        const int z1 = zdiv == 1 ? z : (int)__umulhi((unsigned)z, mzdiv), z2 = z - z1 * zdiv;
        u.A = Ab + (size_t)z1 * aZ1 + (size_t)z2 * aZ2 + (size_t)pm * aTile; u.B = Bb + (size_t)z1 * bZ1 + (size_t)z2 * bZ2 + (size_t)pn * bTile;
        u.pm = pm; u.pn = pn; u.z1 = z1; u.z2 = z2; return true;
    };
    unsigned voffA[2], voffB[2];
#pragma unroll
    for (int i = 0; i < 2; ++i) { int R, C; stage_rc(tid * 16 + i * 8192, R, C); const int Rb = (epi != E_F32 && epi != E_FFN) ? ((R & ~31) + perm32(R & 31)) : R;
        voffA[i] = (unsigned)(R * lda + C) * 2u; voffB[i] = (unsigned)(Rb * ldb + C) * 2u; }
    const size_t kstep = (size_t)(BK * 2);
    const size_t hstepA = (size_t)HALF * lda * 2, hstepB = (size_t)d.bhalf * ldb * 2;
    const unsigned ldsw = (unsigned)wid * 1024u;
    const int aoff = lds_byte(wr * 64 + fr, fq * 8), boff = lds_byte(wc * 32 + fr, fq * 8);
#define PG8_SA(b, h) (((b) * 2 + (h)) * HTB)
#define PG8_SB(b, h) ((4 + (b) * 2 + (h)) * HTB)
#define PG8_STAGE(bufoff, gbase, voff) do { _Pragma("unroll") for (int _i = 0; _i < 2; ++_i) \
        __builtin_amdgcn_global_load_lds((const unsigned*)((const char*)(gbase) + (voff)[_i]), (LAS unsigned*)(lds + (bufoff) + ldsw + _i * 8192), 16, 0, 0); } while (0)
#define PG8_LDA(dst, b, h) do { _Pragma("unroll") for (int m = 0; m < 4; ++m) _Pragma("unroll") for (int k = 0; k < 2; ++k) dst[m][k] = *(const LAS bf16x8*)(lds + PG8_SA(b, h) + aoff + m * 2048 + k * 1024); } while (0)
#define PG8_LDB(dst, b, h) do { _Pragma("unroll") for (int n = 0; n < 2; ++n) _Pragma("unroll") for (int k = 0; k < 2; ++k) dst[n][k] = *(const LAS bf16x8*)(lds + PG8_SB(b, h) + boff + n * 2048 + k * 1024); } while (0)
#define PG8_MMA(ai, bj, At, Bt) do { __builtin_amdgcn_s_setprio(1); _Pragma("unroll") for (int m = 0; m < 4; ++m) _Pragma("unroll") for (int n = 0; n < 2; ++n) _Pragma("unroll") for (int k = 0; k < 2; ++k) \
        acc[ai][bj][m][n] = __builtin_amdgcn_mfma_f32_16x16x32_bf16(Bt[n][k], At[m][k], acc[ai][bj][m][n], 0, 0, 0); __builtin_amdgcn_s_setprio(0); } while (0)
#define PG8_WAIT_V(n) asm volatile("s_waitcnt vmcnt(" #n ")" ::: "memory")
#define PG8_WAIT_L(n) asm volatile("s_waitcnt lgkmcnt(" #n ")" ::: "memory")
#define PG8_BAR __builtin_amdgcn_s_barrier()
#define PG8_SCHED __builtin_amdgcn_sched_barrier(0)
    Unit cur, nxt; int ui = 0;
    if (!next(0, cur)) return;
    f32x4 acc[2][2][4][2];
#pragma unroll
    for (int a = 0; a < 2; ++a)
#pragma unroll
        for (int b = 0; b < 2; ++b)
#pragma unroll
            for (int m = 0; m < 4; ++m)
#pragma unroll
                for (int n = 0; n < 2; ++n) acc[a][b][m][n] = (f32x4){0.f, 0.f, 0.f, 0.f};
    bf16x8 At[4][2], B0[2][2], B1[2][2];
    const char* cA = cur.A; const char* cB = cur.B;
    PG8_STAGE(PG8_SB(0, 0), cB, voffB); PG8_STAGE(PG8_SA(0, 0), cA, voffA); PG8_STAGE(PG8_SB(0, 1), cB + hstepB, voffB); PG8_STAGE(PG8_SA(0, 1), cA + hstepA, voffA);
    if (wr == 1) PG8_BAR;
    PG8_WAIT_V(4); PG8_BAR;
    PG8_STAGE(PG8_SB(1, 0), cB + kstep, voffB); PG8_STAGE(PG8_SA(1, 0), cA + kstep, voffA); PG8_STAGE(PG8_SB(1, 1), cB + hstepB + kstep, voffB);
    PG8_WAIT_V(6); PG8_BAR;
    for (;;) {
        const bool has_next = next(ui + 1, nxt);
        const char* nA = has_next ? nxt.A : cA; const char* nB = has_next ? nxt.B : cB;
        for (int t = 0; t < nt; t += 2) {
            const bool last = (t == nt - 2);
            const char* a1 = cA + (size_t)(t + 1) * kstep;
            const char* a2 = last ? nA : cA + (size_t)(t + 2) * kstep; const char* b2 = last ? nB : cB + (size_t)(t + 2) * kstep;
            const char* a3 = a2 + kstep; const char* b3 = b2 + kstep;
            PG8_LDB(B0, 0, 0); PG8_SCHED; PG8_LDA(At, 0, 0); PG8_STAGE(PG8_SA(1, 1), a1 + hstepA, voffA);
            PG8_WAIT_L(8); PG8_BAR; PG8_WAIT_L(0); PG8_MMA(0, 0, At, B0); PG8_BAR; PG8_SCHED;
            PG8_LDB(B1, 0, 1); PG8_STAGE(PG8_SB(0, 0), b2, voffB);
            PG8_BAR; PG8_WAIT_L(0); PG8_MMA(0, 1, At, B1); PG8_BAR;
            PG8_LDA(At, 0, 1); PG8_STAGE(PG8_SA(0, 0), a2, voffA);
            PG8_BAR; PG8_WAIT_L(0); PG8_MMA(1, 0, At, B0); PG8_BAR; PG8_SCHED;
            PG8_STAGE(PG8_SB(0, 1), b2 + hstepB, voffB);
            PG8_WAIT_V(6); PG8_BAR; PG8_MMA(1, 1, At, B1); PG8_BAR;
            PG8_LDB(B0, 1, 0); PG8_SCHED; PG8_LDA(At, 1, 0); PG8_STAGE(PG8_SA(0, 1), a2 + hstepA, voffA);
            PG8_WAIT_L(8); PG8_BAR; PG8_WAIT_L(0); PG8_MMA(0, 0, At, B0); PG8_BAR; PG8_SCHED;
            PG8_LDB(B1, 1, 1); PG8_STAGE(PG8_SB(1, 0), b3, voffB);
            PG8_BAR; PG8_WAIT_L(0); PG8_MMA(0, 1, At, B1); PG8_BAR;
            PG8_LDA(At, 1, 1); PG8_STAGE(PG8_SA(1, 0), a3, voffA);
            PG8_BAR; PG8_WAIT_L(0); PG8_MMA(1, 0, At, B0); PG8_BAR; PG8_SCHED;
            PG8_STAGE(PG8_SB(1, 1), b3 + hstepB, voffB);
            PG8_WAIT_V(6); PG8_BAR; PG8_MMA(1, 1, At, B1); PG8_BAR;
        }
        {
            int zE; asm volatile("s_mov_b32 %0, 0" : "=s"(zE));
            const GemmDesc& de = p.g[garg + zE];
            char* Cb = de.C + (size_t)chunk * de.cCh;
            if (epi == E_BF16) epi_bf16(acc, cur, Cb, de.cZ1, de.cZ2, de.ldc, de.gelu_pn, wr, wc, fr, fq);
            else if (epi == E_RESID) epi_resid(acc, cur, Cb, de.ldc, de.bias, wr, wc, fr, fq);
            else if (epi == E_F32) epi_f32(acc, cur, Cb, de.cZ1, de.cZ2, de.ldc, wr, wc, fr, fq);
            else if (epi == E_DFT) epi_dft(acc, cur, Cb, de.cZ1, wr, wc, fr, fq);
            else if (epi == E_FFN) { const int layer = de.gelu_pn; epi_ffn(acc, cur, Cb, p.in[23 + zE] + layer * 3 * DFF, p.in[24 + zE] + layer * DFF, p.edge + zE, (long)de.nM * 2 * DFF, (LAS float*)(lds + STAGE_BYTES), wr, wc, fr, fq); }
            else if (epi == E_SOFTMAX) epi_softmax(acc, cur, Cb, de.cZ1, de.cZ2, de.ldc, (LAS float*)(lds + STAGE_BYTES), wr, wc, fr, fq);
            else { const long Tc = (long)(p.CB + zE) * SEQ; epi_gate(acc, cur, (const bf16_t*)(de.A + (size_t)chunk * de.aCh), (unsigned*)Cb, p.in[11 + zE], p.in[13 + zE], p.c8sp + zE, Tc, wr, wc, fr, fq); }
        }
        if (!has_next) break;
#pragma unroll
        for (int a = 0; a < 2; ++a)
#pragma unroll
            for (int b = 0; b < 2; ++b)
#pragma unroll
                for (int m = 0; m < 4; ++m)
#pragma unroll
                    for (int n = 0; n < 2; ++n) acc[a][b][m][n] = (f32x4){0.f, 0.f, 0.f, 0.f};
        cur = nxt; cA = nA; cB = nB; ++ui;
    }
    PG8_WAIT_V(0);
    if (wr == 0) PG8_BAR;
    PG8_BAR;
#undef PG8_SA
#undef PG8_SB
#undef PG8_STAGE
#undef PG8_LDA
#undef PG8_LDB
#undef PG8_MMA
#undef PG8_WAIT_V
#undef PG8_WAIT_L
#undef PG8_BAR
#undef PG8_SCHED
}

__device__ void transpose_job(const int bid, const int nblk, float* tile, const float* __restrict__ src, bf16_t* __restrict__ dst, int K, int N, int nb, long dstB, float scale) {
    const int tk = K / 64, tn = N / 64, per = tk * tn, tot = per * nb, tid = tid_();
    const int kk = tid >> 6, nn = tid & 63;
    float r[8];
    int t = bid;
    if (t < tot) { const int b = t / per, l = t - b * per, k0 = (l / tn) * 64, n0 = (l % tn) * 64; const float* s = src + (long)b * K * N;
#pragma unroll
        for (int i = 0; i < 8; ++i) r[i] = s[(long)(k0 + kk + 8 * i) * N + n0 + nn]; }
    while (t < tot) {
        const int b = t / per, l = t - b * per, k0 = (l / tn) * 64, n0 = (l % tn) * 64;
        bf16_t* d = dst + (long)b * dstB;
#pragma unroll
        for (int i = 0; i < 8; ++i) tile[(kk + 8 * i) * 65 + nn] = r[i];
        __syncthreads();
        const int t2 = t + nblk;
        if (t2 < tot) { const int b2 = t2 / per, l2 = t2 - b2 * per, k2 = (l2 / tn) * 64, n2 = (l2 % tn) * 64; const float* s2 = src + (long)b2 * K * N;
#pragma unroll
            for (int i = 0; i < 8; ++i) r[i] = s2[(long)(k2 + kk + 8 * i) * N + n2 + nn]; }
#pragma unroll
        for (int i = 0; i < 8; ++i) { const int n = kk + 8 * i, k = nn; d[(long)(n0 + n) * K + k0 + k] = f2bf(tile[k * 65 + n] * scale); }
        __syncthreads();
        t = t2;
    }
}

__device__ __forceinline__ float wave_sum(float v) {
#pragma unroll
    for (int o = 32; o > 0; o >>= 1) v += __shfl_xor(v, o, 64);
    return v;
}
__device__ __forceinline__ float wave_max(float v) {
#pragma unroll
    for (int o = 32; o > 0; o >>= 1) v = fmaxf(v, __shfl_xor(v, o, 64));
    return v;
}

__device__ void rms_phase(const int bid, const int nblk, long g0, long nrows, const float* __restrict__ src0, const float* __restrict__ src1, long split, const float* __restrict__ gain,
                          bf16_t* __restrict__ dst, bf16_t* __restrict__ cpy) {
    const int wid = tid_() >> 6, lane = tid_() & 63;
    f32x4 gv[4];
#pragma unroll
    for (int i = 0; i < 4; ++i) gv[i] = *(const f32x4*)(gain + i * 256 + lane * 4);
    const long stride = (long)nblk * 8;
    for (long r = (long)bid * 8 + wid; r < nrows; r += 2 * stride) {
        const long rr[2] = {r, r + stride};
        f32x4 v[2][4];
#pragma unroll
        for (int q = 0; q < 2; ++q) if (rr[q] < nrows) {
            const long gr = g0 + rr[q];
            const float* s = gr < split ? src0 + gr * DM : src1 + (gr - split) * DM;
#pragma unroll
            for (int i = 0; i < 4; ++i) v[q][i] = *(const f32x4*)(s + i * 256 + lane * 4);
        }
#pragma unroll
        for (int q = 0; q < 2; ++q) if (rr[q] < nrows) {
            float ss = 0.f;
#pragma unroll
            for (int i = 0; i < 4; ++i) ss += v[q][i][0] * v[q][i][0] + v[q][i][1] * v[q][i][1] + v[q][i][2] * v[q][i][2] + v[q][i][3] * v[q][i][3];
            ss = wave_sum(ss);
            const float rs = rsqrtf(ss * (1.0f / DM) + 1e-6f);
#pragma unroll
            for (int i = 0; i < 4; ++i) {
                u32x2 w; w.x = cvt_pk_bf16(v[q][i][0] * rs * gv[i][0], v[q][i][1] * rs * gv[i][1]); w.y = cvt_pk_bf16(v[q][i][2] * rs * gv[i][2], v[q][i][3] * rs * gv[i][3]);
                *(u32x2*)(dst + rr[q] * DM + i * 256 + lane * 4) = w;
                if (cpy) { u32x2 c; c.x = cvt_pk_bf16(v[q][i][0], v[q][i][1]); c.y = cvt_pk_bf16(v[q][i][2], v[q][i][3]); *(u32x2*)(cpy + rr[q] * DM + i * 256 + lane * 4) = c; }
            }
        }
    }
}
__device__ void rms_bf_phase(const int bid, const int nblk, long nrows, const bf16_t* __restrict__ X, const float* __restrict__ gain, bf16_t* __restrict__ dst) {
    const int wid = tid_() >> 6, lane = tid_() & 63;
    f32x4 gv[4];
#pragma unroll
    for (int i = 0; i < 2; ++i) { gv[2 * i] = *(const f32x4*)(gain + i * 512 + lane * 8); gv[2 * i + 1] = *(const f32x4*)(gain + i * 512 + lane * 8 + 4); }
    const long stride = (long)nblk * 8;
    for (long r = (long)bid * 8 + wid; r < nrows; r += 2 * stride) {
        const long rr[2] = {r, r + stride};
        u32x4 v[2][2];
#pragma unroll
        for (int q = 0; q < 2; ++q) if (rr[q] < nrows) {
#pragma unroll
            for (int i = 0; i < 2; ++i) v[q][i] = *(const u32x4*)(X + rr[q] * DM + i * 512 + lane * 8);
        }
#pragma unroll
        for (int q = 0; q < 2; ++q) if (rr[q] < nrows) {
            float f[16]; float ss = 0.f;
#pragma unroll
            for (int i = 0; i < 2; ++i)
#pragma unroll
                for (int k = 0; k < 4; ++k) { f[i * 8 + 2 * k] = bflo(v[q][i][k]); f[i * 8 + 2 * k + 1] = bfhi(v[q][i][k]); }
#pragma unroll
            for (int k = 0; k < 16; ++k) ss += f[k] * f[k];
            ss = wave_sum(ss);
            const float rs = rsqrtf(ss * (1.0f / DM) + 1e-6f);
#pragma unroll
            for (int i = 0; i < 2; ++i) {
                u32x4 w;
                w.x = cvt_pk_bf16(f[i * 8 + 0] * rs * gv[2 * i][0], f[i * 8 + 1] * rs * gv[2 * i][1]); w.y = cvt_pk_bf16(f[i * 8 + 2] * rs * gv[2 * i][2], f[i * 8 + 3] * rs * gv[2 * i][3]);
                w.z = cvt_pk_bf16(f[i * 8 + 4] * rs * gv[2 * i + 1][0], f[i * 8 + 5] * rs * gv[2 * i + 1][1]); w.w = cvt_pk_bf16(f[i * 8 + 6] * rs * gv[2 * i + 1][2], f[i * 8 + 7] * rs * gv[2 * i + 1][3]);
                *(u32x4*)(dst + rr[q] * DM + i * 512 + lane * 8) = w;
            }
        }
    }
}
__device__ void final_norm_phase(const int bid, const int nblk, const bf16_t* __restrict__ X, float* __restrict__ y, long nrows, const float* __restrict__ gain) {
    const int wid = tid_() >> 6, lane = tid_() & 63;
    f32x4 gv[4];
#pragma unroll
    for (int i = 0; i < 2; ++i) { gv[2 * i] = *(const f32x4*)(gain + i * 512 + lane * 8); gv[2 * i + 1] = *(const f32x4*)(gain + i * 512 + lane * 8 + 4); }
    for (long r = (long)bid * 8 + wid; r < nrows; r += (long)nblk * 8) {
        u32x4 v[2];
#pragma unroll
        for (int i = 0; i < 2; ++i) v[i] = *(const u32x4*)(X + r * DM + i * 512 + lane * 8);
        float f[16]; float ss = 0.f;
#pragma unroll
        for (int i = 0; i < 2; ++i)
#pragma unroll
            for (int k = 0; k < 4; ++k) { f[i * 8 + 2 * k] = bflo(v[i][k]); f[i * 8 + 2 * k + 1] = bfhi(v[i][k]); }
#pragma unroll
        for (int k = 0; k < 16; ++k) ss += f[k] * f[k];
        ss = wave_sum(ss);
        const float rs = rsqrtf(ss * (1.0f / DM) + 1e-6f);
#pragma unroll
        for (int i = 0; i < 2; ++i) {
            f32x4 o0, o1;
#pragma unroll
            for (int j = 0; j < 4; ++j) { o0[j] = f[i * 8 + j] * rs * gv[2 * i][j]; o1[j] = f[i * 8 + 4 + j] * rs * gv[2 * i + 1][j]; }
            *(f32x4*)(y + r * DM + i * 512 + lane * 8) = o0; *(f32x4*)(y + r * DM + i * 512 + lane * 8 + 4) = o1;
        }
    }
}
__device__ void dft_row1024_job(const int bid, const int nblk, const bf16_t* __restrict__ YT, bf16_t* __restrict__ F, int CB) {
    const int wid = tid_() >> 6, lane = tid_() & 63;
    const int nrow = CB * DM;
    for (int r = bid * 8 + wid; r < nrow; r += nblk * 8) {
        const bf16_t* y = YT + (long)r * (2 * SEQ) + lane * 8;
        float s = 0.f;
#pragma unroll
        for (int i = 0; i < 4; ++i) { const u32x4 w = *(const u32x4*)(y + i * 512);
#pragma unroll
            for (int k = 0; k < 4; ++k) s += bflo(w[k]) - bfhi(w[k]); }
        s = wave_sum(s);
        if (lane == 0) { const int bi = r >> 10, gc = r & 1023; F[((long)bi * SEQ + 1024) * DM + gc] = f2bf(s * 0.022097086912f); }
    }
}
__device__ void softmax_phase(const int bid, const int nblk, const float* __restrict__ S, bf16_t* __restrict__ P, long nrh) {
    const int wid = tid_() >> 6, lane = tid_() & 63;
    for (long r = (long)bid * 8 + wid; r < nrh; r += (long)nblk * 8) {
        f32x4 v = *(const f32x4*)(S + r * 256 + lane * 4);
        float mx = wave_max(fmaxf(fmaxf(v[0], v[1]), fmaxf(v[2], v[3])));
        f32x4 e; for (int j = 0; j < 4; ++j) e[j] = __expf(v[j] - mx);
        const float inv = 1.0f / wave_sum(e[0] + e[1] + e[2] + e[3]);
        u32x2 w; w.x = cvt_pk_bf16(e[0] * inv, e[1] * inv); w.y = cvt_pk_bf16(e[2] * inv, e[3] * inv);
        *(u32x2*)(P + r * 256 + lane * 4) = w;
    }
}
__device__ void ffn_conv_phase(const int bid, const int nblk, bf16_t* __restrict__ GV, long Tc, const float* __restrict__ cw, const float* __restrict__ cb) {
    const long tot = (Tc / 4) * (DFF / 8);
    for (long i = (long)bid * 512 + tid_(); i < tot; i += (long)nblk * 512) {
        const long t4 = i / (DFF / 8); const int f = (int)(i - t4 * (DFF / 8)) * 8; const long t = t4 * 4; const int pos = (int)(t & (SEQ - 1));
        bf16_t* g = GV + t * (2 * DFF) + f;
        const u32x4 z = {0u, 0u, 0u, 0u};
        u32x4 gr[6], vr[4];
        gr[0] = pos > 0 ? *(const u32x4*)(g - 2 * DFF) : z;
#pragma unroll
        for (int q = 0; q < 4; ++q) { gr[q + 1] = *(const u32x4*)(g + (long)q * 2 * DFF); vr[q] = *(const u32x4*)(g + (long)q * 2 * DFF + DFF); }
        gr[5] = pos + 4 < SEQ ? *(const u32x4*)(g + (long)4 * 2 * DFF) : z;
        float w0[8], w1[8], w2[8], bb[8];
#pragma unroll
        for (int j = 0; j < 8; ++j) { w0[j] = cw[f + j]; w1[j] = cw[DFF + f + j]; w2[j] = cw[2 * DFF + f + j]; bb[j] = cb[f + j]; }
#pragma unroll
        for (int q = 0; q < 4; ++q) {
            float o[8];
#pragma unroll
            for (int j = 0; j < 8; ++j) {
                const unsigned a0 = gr[q][j >> 1], a1 = gr[q + 1][j >> 1], a2 = gr[q + 2][j >> 1], av = vr[q][j >> 1];
                const float x0 = (j & 1) ? bfhi(a0) : bflo(a0), x1 = (j & 1) ? bfhi(a1) : bflo(a1), x2 = (j & 1) ? bfhi(a2) : bflo(a2), xv = (j & 1) ? bfhi(av) : bflo(av);
                o[j] = gelu_tanh(x0 * w0[j] + x1 * w1[j] + x2 * w2[j] + bb[j]) * xv;
            }
            u32x4 w; w.x = cvt_pk_bf16(o[0], o[1]); w.y = cvt_pk_bf16(o[2], o[3]); w.z = cvt_pk_bf16(o[4], o[5]); w.w = cvt_pk_bf16(o[6], o[7]);
            *(u32x4*)(g + (long)q * 2 * DFF + DFF) = w;
        }
    }
}
__device__ void ffn_fix_phase(const int bid, const int nblk, bf16_t* __restrict__ H, int nMt, const float* __restrict__ edge, const float* __restrict__ cw) {
    const long edgeN = (long)nMt * 2 * DFF; const long tot = (long)nMt * 2 * (DFF / 4);
    for (long i = (long)bid * 512 + tid_(); i < tot; i += (long)nblk * 512) {
        const int pm = (int)(i / (2 * (DFF / 4))); const int rem = (int)(i - (long)pm * (2 * (DFF / 4))); const int e = rem / (DFF / 4), f = (rem - e * (DFF / 4)) * 4;
        const int sp = pm & 7;
        if ((e == 0 && sp == 0) || (e == 1 && sp == 7)) continue;
        const float* me = edge + ((long)pm * 2 + e) * DFF + f;
        const f32x4 part = *(const f32x4*)(me + edgeN), v = *(const f32x4*)(me + 2 * edgeN);
        const f32x4 gn = e == 0 ? *(const f32x4*)(edge + ((long)(pm - 1) * 2 + 1) * DFF + f) : *(const f32x4*)(edge + ((long)(pm + 1) * 2 + 0) * DFF + f);
        const f32x4 w = *(const f32x4*)(cw + (e == 0 ? 0 : 2 * DFF) + f);
        float o[4];
#pragma unroll
        for (int j = 0; j < 4; ++j) o[j] = gelu_tanh(part[j] + w[j] * gn[j]) * v[j];
        u32x2 ww; ww.x = cvt_pk_bf16(o[0], o[1]); ww.y = cvt_pk_bf16(o[2], o[3]);
        *(u32x2*)(H + ((long)pm * BM + (e == 0 ? 0 : 255)) * DFF + f) = ww;
    }
}
__device__ void lru_conv_phase(const int bid, const int nblk, const bf16_t* __restrict__ U, bf16_t* __restrict__ cbuf, long Tc, const float* __restrict__ cw, const float* __restrict__ cb) {
    const long tot = (Tc / 4) * (DRNN / 8);
    for (long i = (long)bid * 512 + tid_(); i < tot; i += (long)nblk * 512) {
        const long t4 = i / (DRNN / 8); const int f = (int)(i - t4 * (DRNN / 8)) * 8; const long t = t4 * 4; const int pos = (int)(t & (SEQ - 1));
        const bf16_t* g = U + t * (2 * DRNN) + DRNN + f;
        const u32x4 z = {0u, 0u, 0u, 0u};
        u32x4 rr[7];
        rr[0] = pos > 1 ? *(const u32x4*)(g - 4 * DRNN) : z; rr[1] = pos > 0 ? *(const u32x4*)(g - 2 * DRNN) : z;
#pragma unroll
        for (int q = 0; q < 4; ++q) rr[q + 2] = *(const u32x4*)(g + (long)q * 2 * DRNN);
        rr[6] = pos + 4 < SEQ ? *(const u32x4*)(g + (long)4 * 2 * DRNN) : z;
        float w0[8], w1[8], w2[8], w3[8], bb[8];
#pragma unroll
        for (int j = 0; j < 8; ++j) { w0[j] = cw[f + j]; w1[j] = cw[DRNN + f + j]; w2[j] = cw[2 * DRNN + f + j]; w3[j] = cw[3 * DRNN + f + j]; bb[j] = cb[f + j]; }
#pragma unroll
        for (int q = 0; q < 4; ++q) {
            float o[8];
#pragma unroll
            for (int j = 0; j < 8; ++j) {
                const unsigned a0 = rr[q][j >> 1], a1 = rr[q + 1][j >> 1], a2 = rr[q + 2][j >> 1], a3 = rr[q + 3][j >> 1];
                const float x0 = (j & 1) ? bfhi(a0) : bflo(a0), x1 = (j & 1) ? bfhi(a1) : bflo(a1), x2 = (j & 1) ? bfhi(a2) : bflo(a2), x3 = (j & 1) ? bfhi(a3) : bflo(a3);
                o[j] = x0 * w0[j] + x1 * w1[j] + x2 * w2[j] + x3 * w3[j] + bb[j];
            }
            u32x4 w; w.x = cvt_pk_bf16(o[0], o[1]); w.y = cvt_pk_bf16(o[2], o[3]); w.z = cvt_pk_bf16(o[4], o[5]); w.w = cvt_pk_bf16(o[6], o[7]);
            *(u32x4*)(cbuf + (t + q) * DRNN + f) = w;
        }
    }
}
__device__ void scan_phase(const int bid, const int nblk, bf16_t* __restrict__ U, const unsigned* __restrict__ LB, long Tc, int CB, float* sm) {
    const int wid = tid_() >> 6, lane = tid_() & 63;
    const int nitems = CB * (DRNN / 128);
    for (int it = bid; it < nitems; it += nblk) {
        const int bi = it / (DRNN / 128), cgp = it - bi * (DRNN / 128); const int ch = cgp * 128 + lane * 2;
        const long row0 = (long)bi * SEQ + wid * 256;
        const unsigned* lf = LB + row0 * DRNN + ch; const unsigned* lb = lf + Tc * DRNN;
        float Sf0 = 0.f, Sf1 = 0.f, Bf0 = 0.f, Bf1 = 0.f, Sb0 = 0.f, Sb1 = 0.f, Bb0 = 0.f, Bb1 = 0.f;
#pragma unroll 16
        for (int t = 0; t < 256; ++t) {
            const u32x2 w1 = *(const u32x2*)(lf + (long)t * DRNN);
            Bf0 = __expf(bflo(w1.x)) * Bf0 + bfhi(w1.x); Sf0 += bflo(w1.x); Bf1 = __expf(bflo(w1.y)) * Bf1 + bfhi(w1.y); Sf1 += bflo(w1.y);
            const int tb = 255 - t;
            const u32x2 w2 = *(const u32x2*)(lb + (long)tb * DRNN);
            Bb0 = __expf(bflo(w2.x)) * Bb0 + bfhi(w2.x); Sb0 += bflo(w2.x); Bb1 = __expf(bflo(w2.y)) * Bb1 + bfhi(w2.y); Sb1 += bflo(w2.y);
        }
        float* my = sm + (wid * 64 + lane) * 8;
        my[0] = __expf(Sf0); my[1] = Bf0; my[2] = __expf(Sb0); my[3] = Bb0; my[4] = __expf(Sf1); my[5] = Bf1; my[6] = __expf(Sb1); my[7] = Bb1;
        __syncthreads();
        float hf0 = 0.f, hb0 = 0.f, hf1 = 0.f, hb1 = 0.f;
        for (int s = 0; s < wid; ++s) { const float* o = sm + (s * 64 + lane) * 8; hf0 = o[0] * hf0 + o[1]; hf1 = o[4] * hf1 + o[5]; }
        for (int s = 7; s > wid; --s) { const float* o = sm + (s * 64 + lane) * 8; hb0 = o[2] * hb0 + o[3]; hb1 = o[6] * hb1 + o[7]; }
        __syncthreads();
        bf16_t* Ug = U + row0 * (2 * DRNN) + ch;
#pragma unroll 16
        for (int t = 0; t < 256; ++t) {
            const u32x2 w1 = *(const u32x2*)(lf + (long)t * DRNN);
            hf0 = __expf(bflo(w1.x)) * hf0 + bfhi(w1.x); hf1 = __expf(bflo(w1.y)) * hf1 + bfhi(w1.y);
            *(unsigned*)(Ug + (long)t * (2 * DRNN) + DRNN) = cvt_pk_bf16(hf0, hf1);
        }
#pragma unroll 16
        for (int t = 255; t >= 0; --t) {
            const u32x2 w2 = *(const u32x2*)(lb + (long)t * DRNN);
            hb0 = __expf(bflo(w2.x)) * hb0 + bfhi(w2.x); hb1 = __expf(bflo(w2.y)) * hb1 + bfhi(w2.y);
            const unsigned hfw = *(const unsigned*)(Ug + (long)t * (2 * DRNN) + DRNN), gw = *(const unsigned*)(Ug + (long)t * (2 * DRNN));
            *(unsigned*)(Ug + (long)t * (2 * DRNN)) = cvt_pk_bf16((bflo(hfw) + hb0) * bflo(gw), (bfhi(hfw) + hb1) * bfhi(gw));
        }
    }
}

__device__ void lru_fused_phase(const int bid, const int nblk, bf16_t* __restrict__ U, bf16_t* __restrict__ HF, const bf16_t* __restrict__ Wg, const float* __restrict__ cw, const float* __restrict__ cb,
                                const float* __restrict__ b_a, const float* __restrict__ b_i, const float* __restrict__ c8sp, int CB, unsigned char* smem) {
    constexpr int RS = 272;
    const int tid = tid_(), wid = tid >> 6, lane = tid & 63, fr = lane & 15, fq = lane >> 4;
    const int nitems = CB * 10;
    for (int it = bid; it < nitems; it += nblk) {
        const int bi = it / 10, h = it - bi * 10;
        const long rowb = (long)bi * SEQ;
        const int chl = 16 * wid + fr, ch = h * 128 + chl;
        const int sch = h * 128 + 2 * lane;
        float w0[2], w1[2], w2[2], w3[2], wb[2];
#pragma unroll
        for (int q = 0; q < 2; ++q) { w0[q] = cw[sch + q]; w1[q] = cw[DRNN + sch + q]; w2[q] = cw[2 * DRNN + sch + q]; w3[q] = cw[3 * DRNN + sch + q]; wb[q] = cb[sch + q]; }
        const bf16_t* recp = U + rowb * (2 * DRNN) + DRNN + sch;
        for (int e = 0; e < 2; ++e) {
            bf16x8 Bf[2][4];
#pragma unroll
            for (int g = 0; g < 2; ++g)
#pragma unroll
                for (int s = 0; s < 4; ++s) Bf[g][s] = *(const bf16x8*)(Wg + ((long)((e * 10 + h) * 256 + g * 128 + chl)) * 128 + 32 * s + 8 * fq);
            const float ba = b_a[e * DRNN + ch], bi_ = b_i[e * DRNN + ch], sp = c8sp[e * DRNN + ch];
            float hs = 0.f;
            unsigned xr[11];
            {
                const int k = e == 0 ? 0 : 31; const int p0 = 64 * k + 8 * wid - 2;
#pragma unroll
                for (int i = 0; i < 11; ++i) { const int pos = p0 + i; xr[i] = (pos >= 0 && pos < SEQ) ? *(const unsigned*)(recp + (long)pos * (2 * DRNN)) : 0u; }
#pragma unroll
                for (int r = 0; r < 8; ++r) {
                    const float c0 = wb[0] + w0[0] * bflo(xr[r]) + w1[0] * bflo(xr[r + 1]) + w2[0] * bflo(xr[r + 2]) + w3[0] * bflo(xr[r + 3]);
                    const float c1 = wb[1] + w0[1] * bfhi(xr[r]) + w1[1] * bfhi(xr[r + 1]) + w2[1] * bfhi(xr[r + 2]) + w3[1] * bfhi(xr[r + 3]);
                    *(unsigned*)(smem + (8 * wid + r) * RS + lane * 4) = cvt_pk_bf16(c0, c1);
                }
            }
            __syncthreads();
            for (int kk = 0; kk < 32; ++kk) {
                const int k = e == 0 ? kk : 31 - kk;
                unsigned char* buf = smem + (kk & 1) * (64 * RS);
                if (kk + 1 < 32) {
                    const int kn = e == 0 ? kk + 1 : 30 - kk; const int p0 = 64 * kn + 8 * wid - 2;
#pragma unroll
                    for (int i = 0; i < 11; ++i) { const int pos = p0 + i; xr[i] = (pos >= 0 && pos < SEQ) ? *(const unsigned*)(recp + (long)pos * (2 * DRNN)) : 0u; }
                }
#pragma unroll
                for (int rti = 0; rti < 4; ++rti) {
                    const int rt = e == 0 ? rti : 3 - rti;
                    const long grow = rowb + 64 * k + 16 * rt + 4 * fq;
                    unsigned short hfv[4], gtv[4];
                    if (e == 1) {
#pragma unroll
                        for (int j = 0; j < 4; ++j) { hfv[j] = HF[(grow + j) * DRNN + ch]; gtv[j] = U[(grow + j) * (2 * DRNN) + ch]; }
                    }
                    f32x4 za = {0.f, 0.f, 0.f, 0.f}, zi = {0.f, 0.f, 0.f, 0.f};
#pragma unroll
                    for (int s = 0; s < 4; ++s) {
                        const bf16x8 af = *(const bf16x8*)(buf + (16 * rt + fr) * RS + (32 * s + 8 * fq) * 2);
                        za = __builtin_amdgcn_mfma_f32_16x16x32_bf16(af, Bf[0][s], za, 0, 0, 0);
                        zi = __builtin_amdgcn_mfma_f32_16x16x32_bf16(af, Bf[1][s], zi, 0, 0, 0);
                    }
                    float av[4], bv[4];
#pragma unroll
                    for (int j = 0; j < 4; ++j) {
                        const float c = bf2f(*(const unsigned short*)(buf + (16 * rt + 4 * fq + j) * RS + chl * 2));
                        const float r = sigmoidf(za[j] + ba), ig = sigmoidf(zi[j] + bi_);
                        const float la = -sp * r;
                        av[j] = __expf(la);
                        bv[j] = __builtin_sqrtf(fmaxf(1.0f - av[j] * av[j], 0.f)) * ig * c;
                    }
                    float hl[4], pp[4];
                    if (e == 0) { hl[0] = bv[0]; pp[0] = av[0];
#pragma unroll
                        for (int j = 1; j < 4; ++j) { hl[j] = av[j] * hl[j - 1] + bv[j]; pp[j] = av[j] * pp[j - 1]; } }
                    else { hl[3] = bv[3]; pp[3] = av[3];
#pragma unroll
                        for (int j = 2; j >= 0; --j) { hl[j] = av[j] * hl[j + 1] + bv[j]; pp[j] = av[j] * pp[j + 1]; } }
                    const float Ag = e == 0 ? pp[3] : pp[0], Hg = e == 0 ? hl[3] : hl[0];
                    float A4[4], H4[4];
#pragma unroll
                    for (int f = 0; f < 4; ++f) { A4[f] = __shfl(Ag, fr + 16 * f, 64); H4[f] = __shfl(Hg, fr + 16 * f, 64); }
                    float carry, sN;
                    if (e == 0) { const float s0 = hs, s1 = A4[0] * s0 + H4[0], s2 = A4[1] * s1 + H4[1], s3 = A4[2] * s2 + H4[2]; sN = A4[3] * s3 + H4[3];
                        carry = fq == 0 ? s0 : (fq == 1 ? s1 : (fq == 2 ? s2 : s3)); }
                    else { const float t0 = hs, t1 = A4[3] * t0 + H4[3], t2 = A4[2] * t1 + H4[2], t3 = A4[1] * t2 + H4[1]; sN = A4[0] * t3 + H4[0];
                        carry = fq == 3 ? t0 : (fq == 2 ? t1 : (fq == 1 ? t2 : t3)); }
                    hs = sN;
#pragma unroll
                    for (int j = 0; j < 4; ++j) {
                        const float hv = hl[j] + pp[j] * carry;
                        if (e == 0) HF[(grow + j) * DRNN + ch] = f2bf(hv);
                        else U[(grow + j) * (2 * DRNN) + ch] = f2bf((bf2f(hfv[j]) + hv) * bf2f(gtv[j]));
                    }
                }
                if (kk + 1 < 32) {
                    unsigned char* nb = smem + ((kk + 1) & 1) * (64 * RS);
#pragma unroll
                    for (int r = 0; r < 8; ++r) {
                        const float c0 = wb[0] + w0[0] * bflo(xr[r]) + w1[0] * bflo(xr[r + 1]) + w2[0] * bflo(xr[r + 2]) + w3[0] * bflo(xr[r + 3]);
                        const float c1 = wb[1] + w0[1] * bfhi(xr[r]) + w1[1] * bfhi(xr[r + 1]) + w2[1] * bfhi(xr[r + 2]) + w3[1] * bfhi(xr[r + 3]);
                        *(unsigned*)(nb + (8 * wid + r) * RS + lane * 4) = cvt_pk_bf16(c0, c1);
                    }
                }
                __syncthreads();
            }
        }
    }
}

#define XB_TMO      128
#define XB_XCNT(j)  (256  + 64 * (j))
#define XB_XSUB(j)  (1280 + 64 * (j))
#define XB_XGEN(j)  (2304 + 64 * (j))
#define XB_TOP      3328
#define XB_TOPGEN   3392
#define XCD_BAR_WORDS 3456
#define XB_SPIN_CAP (1u << 22)
__device__ __forceinline__ unsigned xb_ld(unsigned* p)              { return __hip_atomic_load(p, __ATOMIC_RELAXED, __HIP_MEMORY_SCOPE_AGENT); }
__device__ __forceinline__ unsigned xb_add(unsigned* p, unsigned v) { return __hip_atomic_fetch_add(p, v, __ATOMIC_RELAXED, __HIP_MEMORY_SCOPE_AGENT); }
__device__ __forceinline__ unsigned xb_xcc_id() { return (unsigned)__builtin_amdgcn_s_getreg((3 << 11) | 20) & 0xFu; }
#define XB_SPIN(cond, bar) do { unsigned _sp = 0; while (cond) { __builtin_amdgcn_s_sleep(1); \
    if ((++_sp & 255u) == 0u) { if (xb_ld(&(bar)[XB_TMO])) break; if (_sp > XB_SPIN_CAP) { atomicAdd(&(bar)[XB_TMO], 1u); break; } } } } while (0)
__device__ __forceinline__ void xcd_barrier_complete(unsigned* bar, unsigned x, unsigned G, unsigned& nloc, unsigned& nx) {
    unsigned sum, cnt, mine, sp = 0u;
    for (;;) {
        sum = 0u; cnt = 0u; mine = 0u;
#pragma unroll
        for (unsigned j = 0; j < 16; ++j) { const unsigned c = xb_ld(&bar[XB_XCNT(j)]); sum += c; cnt += (c > 0u) ? 1u : 0u; mine = (j == x) ? c : mine; }
        if (sum == G) break;
        __builtin_amdgcn_s_sleep(1);
        if ((++sp & 255u) == 0u) { if (xb_ld(&bar[XB_TMO])) break; if (sp > XB_SPIN_CAP) { atomicAdd(&bar[XB_TMO], 1u); break; } }
    }
    nloc = mine > 0u ? mine : 1u; nx = cnt > 0u ? cnt : 1u;
}
__device__ __forceinline__ void xcd_barrier(unsigned* bar, volatile LAS unsigned* st, unsigned G) {
    asm volatile("s_waitcnt vmcnt(0)" ::: "memory");
    __syncthreads();
    if (tid_() == 0) {
        const unsigned x = xb_xcc_id();
        __builtin_amdgcn_s_waitcnt(0);
        unsigned nloc = st[0], nx = st[1];
        if (nloc == 0u) { xcd_barrier_complete(bar, x, G, nloc, nx); st[0] = nloc; st[1] = nx; }
        const unsigned old = xb_add(&bar[XB_XSUB(x)], 1u);
        const unsigned gen = old / nloc;
        if (old + 1u == (gen + 1u) * nloc) {
            __builtin_amdgcn_fence(__ATOMIC_RELEASE, "agent");
            asm volatile("s_waitcnt vmcnt(0)" ::: "memory");
            const unsigned og = xb_add(&bar[XB_TOP], 1u);
            const unsigned tg = og / nx;
            if (og + 1u == (tg + 1u) * nx) xb_add(&bar[XB_TOPGEN], 1u);
            else XB_SPIN(xb_ld(&bar[XB_TOPGEN]) == tg, bar);
            __builtin_amdgcn_fence(__ATOMIC_ACQUIRE, "agent");
            xb_add(&bar[XB_XGEN(x)], 1u);
            asm volatile("s_waitcnt vmcnt(0)" ::: "memory");
        } else {
            XB_SPIN(xb_ld(&bar[XB_XGEN(x)]) == gen, bar);
            __builtin_amdgcn_fence(__ATOMIC_ACQUIRE, "agent");
            asm volatile("s_waitcnt vmcnt(0)" ::: "memory");
        }
    }
    __syncthreads();
}

__device__ __forceinline__ void block_seam() {
    asm volatile("s_waitcnt vmcnt(0)" ::: "memory");
    __syncthreads();
    if (tid_() == 0) { __builtin_amdgcn_fence(__ATOMIC_ACQUIRE, "agent"); asm volatile("s_waitcnt vmcnt(0)" ::: "memory"); }
    __syncthreads();
}

__device__ void prologue_phase(const int bid, const int nblk, const int z0, const Params& p, float* smf) {
    transpose_job(bid, nblk, smf, p.in[5 + z0], p.wp[WP_FNET + z0], DM, DM, 1, 0, 1.0f);
    transpose_job(bid, nblk, smf, p.in[7 + z0], p.wp[WP_IN + z0], DM, 2 * DRNN, 1, 0, 1.0f);
    transpose_job(bid, nblk, smf, p.in[15 + z0], p.wp[WP_LOUT + z0], DRNN, DM, 1, 0, 1.0f);
    transpose_job(bid, nblk, smf, p.in[18 + z0], p.wp[WP_Q + z0], DM, DM, 2, (long)DM * DM, 0.0625f);
    transpose_job(bid, nblk, smf, p.in[19 + z0], p.wp[WP_KV + z0], DM, 2 * DM, 2, (long)2 * DM * DM, 1.0f);
    transpose_job(bid, nblk, smf, p.in[20 + z0], p.wp[WP_O + z0], DM, DM, 2, (long)DM * DM, 1.0f);
    transpose_job(bid, nblk, smf, p.in[22 + z0], p.wp[WP_UP + z0], DM, 2 * DFF, 2, (long)2 * DFF * DM, 1.0f);
    transpose_job(bid, nblk, smf, p.in[25 + z0], p.wp[WP_DOWN + z0], DFF, DM, 2, (long)DFF * DM, 1.0f);
    transpose_job(bid, nblk, smf, p.in[10 + z0], p.wp[WP_GATE + z0], 128, 128, 20, 256 * 128, 1.0f);
    transpose_job(bid, nblk, smf, p.in[12 + z0], p.wp[WP_GATE + z0] + 128 * 128, 128, 128, 20, 256 * 128, 1.0f);
    const long gtid = (long)bid * 512 + tid_(), gth = (long)nblk * 512;
    for (long i = gtid; i < 512 * 256; i += gth) { const int m = (int)(i >> 8), c = (int)(i & 255), cp = m >> 1; const int idx = (c * cp) & 255;
        const float ang = (float)idx * (1.0f / 128.0f); p.wp[WP_CS + z0][i] = f2bf(((m & 1) ? sinpif(ang) : cospif(ang)) * 0.0625f); }
    for (long i = gtid; i < (long)SEQ * 2 * SEQ; i += gth) { const int sp = (int)(i >> 12), k = (int)(i & 4095), s = k & 2047; const int idx = (sp * s) & 2047;
        const float ang = (float)idx * (1.0f / 1024.0f); p.wp[WP_DFTA + z0][i] = f2bf((k < SEQ ? cospif(ang) : -sinpif(ang)) * 0.022097086912f); }
    for (long i = gtid; i < 2 * DRNN; i += gth) p.c8sp[i] = 8.0f * log1pf(__expf(-p.in[14 + z0][i]));
    for (int l = 0; l < 2; ++l)
        rms_phase(bid, nblk, 0, (long)NB * NMEM, p.in[2 + z0], p.in[3 + z0], (long)16 * NMEM, p.in[17 + z0] + l * DM, p.wp[WP_MN + z0] + (long)l * NB * NMEM * DM, nullptr);
}

constexpr int NSTEP = 27;
__global__ __launch_bounds__(512, 2) void mega(Params p) {
    extern __shared__ __attribute__((aligned(16))) unsigned char shm[];
    cg::grid_group grid = cg::this_grid();
    volatile LAS unsigned* st = (volatile LAS unsigned*)((LAS unsigned char*)shm + (LDS_BYTES - 16));
    if (threadIdx.x == 0) { st[0] = 0u; st[1] = 0u; (void)xb_add(&p.bar[XB_XCNT(xb_xcc_id())], 1u); }
    grid.sync();
    const int total = 3 + p.nch * NSTEP;
    for (int pc = 0; pc < total; ++pc) {
        int z0; asm volatile("s_mov_b32 %0, 0" : "=s"(z0));
        const int bid = blockIdx.x + z0, nblk = gridDim.x + z0;
        int kind, arg, chunk;
        if (pc < 3) { kind = pc == 0 ? K_PROLOGUE : K_GEMM; arg = 17 + pc; chunk = 0; }
        else { const int q = pc - 3; chunk = q / NSTEP; const int s = q - chunk * NSTEP; kind = p.kind[s]; arg = p.arg[s]; }
        const int local_seam = arg >> 7; arg &= 0x7f;
        if (kind == K_GEMM) {
            if (arg == 1 && pc >= 3) dft_row1024_job(bid, nblk, (const bf16_t*)(p.R1 + z0), p.wp[WP_R0 + z0], p.CB + z0);
            gemm_phase(bid, nblk, (LAS unsigned char*)shm, arg, chunk, p);
        } else {
            const int CB = p.CB + z0; const long Tc = (long)CB * SEQ; const long r0 = (long)chunk * Tc;
            float* smf = (float*)shm;
            unsigned char* R1 = p.R1 + z0; bf16_t* R0 = p.wp[WP_R0 + z0]; float* out = p.out + z0;
#define IN(k) p.in[(k) + z0]
            switch (kind) {
                case K_PROLOGUE: prologue_phase(bid, nblk, z0, p, smf); break;
                case K_RMS_IN: rms_phase(bid, nblk, r0, Tc, IN(0), IN(1), (long)16 * SEQ, IN(4), R0, p.xr + z0); break;
                case K_RMS_MIX1: rms_bf_phase(bid, nblk, Tc, p.xr + z0, IN(4) + DM, R0); break;
                case K_RMS_XA: rms_bf_phase(bid, nblk, Tc, p.xr + z0, IN(16) + arg * DM, R0); break;
                case K_RMS_FFN: rms_bf_phase(bid, nblk, Tc, p.xr + z0, IN(21) + arg * DM, R0); break;
                case K_SOFTMAX: softmax_phase(bid, nblk, (const float*)(R1 + Tc * 2048), (bf16_t*)R1, Tc * 4); break;
                case K_FFNFIX: ffn_fix_phase(bid, nblk, (bf16_t*)R1, (int)(Tc / BM), p.edge + z0, IN(23) + arg * 3 * DFF); break;
                case K_FFNCONV: ffn_conv_phase(bid, nblk, (bf16_t*)R1, Tc, IN(23) + arg * 3 * DFF, IN(24) + arg * DFF); break;
                case K_LRUCONV: lru_conv_phase(bid, nblk, (const bf16_t*)R1, (bf16_t*)(R1 + Tc * 5120), Tc, IN(8), IN(9)); break;
                case K_LRU: lru_fused_phase(bid, nblk, (bf16_t*)R1, (bf16_t*)(R1 + Tc * 5120), p.wp[WP_GATE + z0], IN(8), IN(9), IN(11), IN(13), p.c8sp + z0, CB, (unsigned char*)shm); break;
                case K_SCAN: scan_phase(bid, nblk, (bf16_t*)R1, (const unsigned*)(R1 + Tc * 7680), Tc, CB, smf); break;
                case K_FINAL: final_norm_phase(bid, nblk, p.xr + z0, out + r0 * DM, Tc, IN(26)); break;
                default: break;
            }
#undef IN
        }
        if (local_seam) block_seam();
        else if (pc != 1 && pc != total - 1) xcd_barrier(p.bar + z0, st, (unsigned)nblk);
    }
}

static GemmDesc mkdesc(const void* A, const void* B, void* C, const float* bias, int nM, int nN, int nZ, int zdiv,
                       long aZ1, long aZ2, long bZ1, long bZ2, long aTile, long bTile, long cZ1, long cZ2, int csz,
                       long aCh, long bCh, long cCh, int K, int lda, int ldb, int ldc, int epi, int gelu_pn) {
    GemmDesc d{};
    d.A = (const char*)A; d.B = (const char*)B; d.C = (char*)C; d.bias = bias;
    d.aZ1 = (unsigned)(aZ1 * 2); d.aZ2 = (unsigned)(aZ2 * 2); d.bZ1 = (unsigned)(bZ1 * 2); d.bZ2 = (unsigned)(bZ2 * 2); d.aTile = (unsigned)(aTile * 2); d.bTile = (unsigned)(bTile * 2);
    d.cZ1 = (unsigned)(cZ1 * csz); d.cZ2 = (unsigned)(cZ2 * csz);
    d.aCh = (unsigned)(aCh * 2); d.bCh = (unsigned)(bCh * 2); d.cCh = (unsigned)(cCh * csz);
    d.bhalf = 128;
    { auto magic = [](unsigned dd) { return (unsigned)((0x100000000ull / dd) + 1ull); };
      d.mper = magic((unsigned)(nM * nN)); d.mnig = magic((unsigned)(8 * nN)); d.mgsz = magic((unsigned)(nM < 8 ? nM : 8)); d.mzdiv = zdiv > 1 ? magic((unsigned)zdiv) : 0u; d.padm = 0u; }
    d.nM = nM; d.nN = nN; d.nZ = nZ; d.zdiv = zdiv; d.K = K; d.lda = lda; d.ldb = ldb; d.ldc = ldc; d.epi = epi; d.gelu_pn = gelu_pn;
    return d;
}

extern "C" void kernel_launch(void* const* d_in, const int* in_sizes, int n_in, void* d_out, int out_size, void* d_ws, size_t ws_size, hipStream_t stream) {
    static int grid = 0;
    if (grid == 0) {
        int dev = 0, cus = 0, per_cu = 0;
        (void)hipGetDevice(&dev);
        (void)hipDeviceGetAttribute(&cus, hipDeviceAttributeMultiprocessorCount, dev);
        if (hipFuncSetAttribute((const void*)mega, hipFuncAttributeMaxDynamicSharedMemorySize, LDS_BYTES) != hipSuccess) { fprintf(stderr, "hipFuncSetAttribute failed\n"); }
        if (hipOccupancyMaxActiveBlocksPerMultiprocessor(&per_cu, (const void*)mega, 512, LDS_BYTES) != hipSuccess || per_cu < 1) per_cu = 1;
        (void)hipGetLastError();
        grid = cus * per_cu;
    }
    Params p{};
    for (int i = 0; i < 27; ++i) p.in[i] = (const float*)d_in[i];
    p.out = (float*)d_out;
    size_t off = 0; unsigned char* ws = (unsigned char*)d_ws;
    auto take = [&](size_t bytes) { unsigned char* r = ws + off; off += (bytes + 255) & ~(size_t)255; return r; };
    p.wp[WP_FNET] = (bf16_t*)take((size_t)DM * DM * 2);
    p.wp[WP_IN] = (bf16_t*)take((size_t)2 * DRNN * DM * 2);
    p.wp[WP_GATE] = (bf16_t*)take((size_t)20 * 256 * 128 * 2);
    p.wp[WP_LOUT] = (bf16_t*)take((size_t)DM * DRNN * 2);
    p.wp[WP_Q] = (bf16_t*)take((size_t)2 * DM * DM * 2);
    p.wp[WP_KV] = (bf16_t*)take((size_t)2 * 2 * DM * DM * 2);
    p.wp[WP_O] = (bf16_t*)take((size_t)2 * DM * DM * 2);
    p.wp[WP_UP] = (bf16_t*)take((size_t)2 * 2 * DFF * DM * 2);
    p.wp[WP_DOWN] = (bf16_t*)take((size_t)2 * DM * DFF * 2);
    p.wp[WP_CS] = (bf16_t*)take((size_t)512 * 256 * 2);
    p.wp[WP_DFTA] = (bf16_t*)take((size_t)SEQ * 2 * SEQ * 2);
    p.c8sp = (float*)take((size_t)2 * DRNN * 4);
    p.bar = (unsigned*)take((size_t)XCD_BAR_WORDS * 4);
    p.wp[WP_MN] = (bf16_t*)take((size_t)2 * NB * NMEM * DM * 2);
    bf16_t* Kmat = (bf16_t*)take((size_t)2 * NB * NMEM * DM * 2);
    bf16_t* VT = (bf16_t*)take((size_t)2 * NB * NMEM * DM * 2);
    const int cands[7] = {48, 24, 16, 8, 4, 2, 1};
    int CB = 1;
    for (int i = 0; i < 7; ++i) { const size_t need = off + (size_t)cands[i] * SEQ * (2048 + 7680 + 544 + 2048) + 8192; if (need <= ws_size) { CB = cands[i]; break; } }
    p.CB = CB; p.nch = NB / CB;
    const long Tc = (long)CB * SEQ; const int nMt = (int)(Tc / BM);
    p.wp[WP_R0] = (bf16_t*)take((size_t)Tc * 2048);
    p.R1 = take((size_t)Tc * 7680);
    p.edge = (float*)take((size_t)3 * nMt * 2 * DFF * 4);
    p.xr = (bf16_t*)take((size_t)Tc * 2048);
    bf16_t* XR = p.xr;
    bf16_t* R0 = p.wp[WP_R0]; unsigned char* R1 = p.R1;
    bf16_t* Ob = (bf16_t*)(R1 + Tc * 4096);
    bf16_t* YT = (bf16_t*)R1; bf16_t* Q = (bf16_t*)R1; bf16_t* Pb = (bf16_t*)(R1 + Tc * 2048); bf16_t* GV = (bf16_t*)R1;
    bf16_t* U = (bf16_t*)R1; bf16_t* cbuf = (bf16_t*)(R1 + Tc * 5120); bf16_t* LA = (bf16_t*)(R1 + Tc * 7680);
    float* out = p.out;
    const long MD = (long)NMEM * DM, SD = (long)SEQ * DM;
    p.g[0] = mkdesc(p.wp[WP_CS], R0, YT, nullptr, 2, 8, CB * 4, 4, 0, 0, SD, 256, 256 * 256, 256 * DM, (long)4 * 512 * SEQ, (long)512 * SEQ, 2, 0, 0, 0, 256, 256, DM, SEQ, E_BF16, 0);
    p.g[1] = mkdesc(p.wp[WP_DFTA], YT, R0, nullptr, 4, 4, CB, 1, 0, 0, (long)DM * 2 * SEQ, 0, (long)256 * 2 * SEQ, (long)256 * 2 * SEQ, SD, 0, 2, 0, 0, 0, 2 * SEQ, 2 * SEQ, 2 * SEQ, DM, E_DFT, 0);
    p.g[2] = mkdesc(R0, p.wp[WP_FNET], XR, p.in[6], nMt, 4, 1, 1, 0, 0, 0, 0, 256 * DM, 256 * DM, 0, 0, 2, 0, 0, 0, DM, DM, DM, DM, E_RESID, 0);
    for (int l = 0; l < 2; ++l) {
        const int b = 3 + l * 6;
        p.g[b + 0] = mkdesc(R0, p.wp[WP_Q] + (long)l * DM * DM, Q, nullptr, nMt, 4, 1, 1, 0, 0, 0, 0, 256 * DM, 256 * DM, 0, 0, 2, 0, 0, 0, DM, DM, DM, DM, E_BF16, 0);
        p.g[b + 1] = mkdesc(Q, Kmat + (long)l * NB * MD, Pb, nullptr, 8, 1, CB * 4, 4, SD, 256, MD, 256, 256 * DM, 0, SD, 256, 2, 0, (long)CB * MD, 0, 256, DM, DM, DM, E_SOFTMAX, 0);
        p.g[b + 2] = mkdesc(Pb, VT + (long)l * NB * MD, Ob, nullptr, 8, 1, CB * 4, 4, SD, 256, MD, (long)256 * NMEM, 256 * DM, 0, SD, 256, 2, 0, (long)CB * MD, 0, 256, DM, NMEM, DM, E_BF16, 0);
        p.g[b + 3] = mkdesc(Ob, p.wp[WP_O] + (long)l * DM * DM, XR, nullptr, nMt, 4, 1, 1, 0, 0, 0, 0, 256 * DM, 256 * DM, 0, 0, 2, 0, 0, 0, DM, DM, DM, DM, E_RESID, 0);
        p.g[b + 4] = mkdesc(R0, p.wp[WP_UP] + (long)l * 2 * DFF * DM, GV, nullptr, nMt, 22, 1, 1, 0, 0, 0, 0, 256 * DM, 128 * DM, 0, 0, 2, 0, 0, 0, DM, DM, DM, DFF, E_FFN, l);
        p.g[b + 4].bhalf = DFF;
        p.g[b + 5] = mkdesc(GV, p.wp[WP_DOWN] + (long)l * DM * DFF, XR, nullptr, nMt, 4, 1, 1, 0, 0, 0, 0, (long)256 * DFF, (long)256 * DFF, 0, 0, 2, 0, 0, 0, DFF, DFF, DFF, DM, E_RESID, 0);
    }
    p.g[15] = mkdesc(R0, p.wp[WP_IN], U, nullptr, nMt, 10, 1, 1, 0, 0, 0, 0, 256 * DM, 256 * DM, 0, 0, 2, 0, 0, 0, DM, DM, DM, 2 * DRNN, E_BF16, 5);
    p.g[16] = mkdesc(cbuf, p.wp[WP_GATE], LA, nullptr, nMt, 1, 20, 10, 0, 128, (long)10 * 256 * 128, (long)256 * 128, (long)256 * DRNN, 0, 0, 0, 2, 0, 0, 0, 128, DRNN, 128, DRNN, E_GATE, 0);
    p.g[17] = mkdesc(U, p.wp[WP_LOUT], XR, nullptr, nMt, 4, 1, 1, 0, 0, 0, 0, (long)256 * 2 * DRNN, (long)256 * DRNN, 0, 0, 2, 0, 0, 0, DRNN, 2 * DRNN, DRNN, DM, E_RESID, 0);
    p.g[18] = mkdesc(p.wp[WP_MN], p.wp[WP_KV], Kmat, nullptr, NB, 4, 2, 1, (long)NB * MD, 0, (long)2 * DM * DM, 0, 256 * DM, 256 * DM, (long)NB * MD, 0, 2, 0, 0, 0, DM, DM, DM, DM, E_BF16, 0);
    p.g[19] = mkdesc(p.wp[WP_KV] + (long)DM * DM, p.wp[WP_MN], VT, nullptr, 4, 1, 2 * NB, NB, (long)2 * DM * DM, 0, (long)NB * MD, MD, 256 * DM, 0, (long)NB * MD, MD, 2, 0, 0, 0, DM, DM, DM, NMEM, E_BF16, 0);
    const unsigned char kinds[NSTEP] = {K_RMS_IN, K_GEMM, K_GEMM, K_GEMM, K_RMS_XA, K_GEMM, K_GEMM, K_GEMM, K_GEMM, K_RMS_FFN, K_GEMM, K_FFNFIX, K_GEMM,
                                         K_RMS_MIX1, K_GEMM, K_LRU, K_GEMM, K_RMS_XA, K_GEMM, K_GEMM, K_GEMM, K_GEMM, K_RMS_FFN, K_GEMM, K_FFNFIX, K_GEMM, K_FINAL};
    const unsigned char LS = 0x80;
    const unsigned char args_[NSTEP] = {0, 0, 1, 2, 0, (unsigned char)(3 | LS), (unsigned char)(4 | LS), 5, 6, 0, 7, 0, 8,
                                         0, 15, 0, 17, 1, (unsigned char)(9 | LS), (unsigned char)(10 | LS), 11, 12, 1, 13, 1, 14, 0};
    for (int i = 0; i < NSTEP; ++i) { p.kind[i] = kinds[i]; p.arg[i] = args_[i]; }
    (void)hipMemsetAsync(p.bar, 0, (size_t)XCD_BAR_WORDS * 4, stream);
    void* args[] = {&p};
    hipError_t e = hipLaunchCooperativeKernel((const void*)mega, dim3(grid), dim3(512), args, LDS_BYTES, stream);
    if (e != hipSuccess) fprintf(stderr, "cooperative launch failed: %s (grid %d)\n", hipGetErrorString(e), grid);
}
```

```cpp
#include <hip/hip_runtime.h>
#include <hip/hip_cooperative_groups.h>
#include <cstdio>
namespace cg = cooperative_groups;

#define LAS __attribute__((address_space(3)))
typedef unsigned short bf16_t;
typedef short bf16x8 __attribute__((ext_vector_type(8)));
typedef float f32x4 __attribute__((ext_vector_type(4)));
typedef unsigned u32x4 __attribute__((ext_vector_type(4)));
typedef unsigned u32x2 __attribute__((ext_vector_type(2)));

constexpr int BM = 256, BK = 64, HALF = 128, HTB = HALF * BK * 2, STAGE_BYTES = 8 * HTB;
constexpr int LDS_BYTES = STAGE_BYTES + 8192;
constexpr int NB = 48, SEQ = 2048, DM = 1024, NMEM = 256, DRNN = 1280, DFF = 2816;

__device__ __forceinline__ int lds_byte(int r, int c) { const int st = (r >> 4) * 2 + (c >> 5), rr = r & 15, cc = c & 31, ob = rr * 64 + cc * 2; return st * 1024 + (ob ^ (((ob >> 9) & 1) << 5)); }
__device__ __forceinline__ void stage_rc(int b, int& R, int& C) { const int st = b / 1024, sb = b % 1024, swz = sb ^ (((sb >> 9) & 1) << 5); R = (st >> 1) * 16 + swz / 64; C = (st & 1) * 32 + (swz % 64) / 2; }
__device__ __forceinline__ int perm32(int rho) { const int n = rho >> 4, i = rho & 15; return 8 * (i >> 2) + 4 * n + (i & 3); }
__device__ __forceinline__ unsigned cvt_pk_bf16(float lo, float hi) { unsigned r; asm volatile("v_cvt_pk_bf16_f32 %0, %1, %2" : "=v"(r) : "v"(lo), "v"(hi)); return r; }
__device__ __forceinline__ bf16_t f2bf(float f) { unsigned u = __float_as_uint(f); u += 0x7FFFu + ((u >> 16) & 1u); return (bf16_t)(u >> 16); }
__device__ __forceinline__ float bf2f(bf16_t b) { return __uint_as_float(((unsigned)b) << 16); }
__device__ __forceinline__ float bflo(unsigned w) { return __uint_as_float(w << 16); }
__device__ __forceinline__ float bfhi(unsigned w) { return __uint_as_float(w & 0xffff0000u); }
__device__ __forceinline__ float gelu_tanh(float x) { const float u = 1.5957691216f * (x + 0.044715f * x * x * x); return x * __builtin_amdgcn_rcpf(1.0f + __expf(-u)); }
typedef float f32x2 __attribute__((ext_vector_type(2)));
__device__ __forceinline__ f32x2 gelu_tanh2(f32x2 x) {
    const f32x2 t = x * x;
    const f32x2 w = x * (t * (-0.10294324f) + (-2.3022082f));
    f32x2 e; e.x = __builtin_amdgcn_exp2f(w.x); e.y = __builtin_amdgcn_exp2f(w.y);
    const f32x2 d = e + 1.0f;
    f32x2 r; r.x = __builtin_amdgcn_rcpf(d.x); r.y = __builtin_amdgcn_rcpf(d.y);
    return x * r;
}
__device__ __forceinline__ int tid_() { int t = threadIdx.x; asm volatile("" : "+v"(t)); return t; }
__device__ __forceinline__ float sigmoidf(float z) { return __builtin_amdgcn_rcpf(1.0f + __expf(-z)); }


struct GemmDesc {
    const char* A; const char* B; char* C; const float* bias;
    unsigned aZ1, aZ2, bZ1, bZ2, aTile, bTile, cZ1, cZ2;
    unsigned aCh, bCh, cCh;
    int nM, nN, nZ, zdiv, K, lda, ldb, ldc, epi, gelu_pn, bhalf;
    unsigned mper, mnig, mgsz, mzdiv, padm;
};
struct Params {
    const float* in[27];
    float* out;
    bf16_t* wp[14];
    unsigned char* R1;
    float* c8sp;
    bf16_t* xr;
    float* edge;
    unsigned* bar;
    int CB, nch;
    unsigned char kind[32]; unsigned char arg[32];
    GemmDesc g[20];
};
enum { WP_FNET = 0, WP_IN, WP_GATE, WP_LOUT, WP_Q, WP_KV, WP_O, WP_UP, WP_DOWN, WP_CS, WP_DFTA, WP_MN, WP_R0, WP_PAD };
enum { K_GEMM = 0, K_PROLOGUE, K_RMS_IN, K_RMS_XA, K_RMS_FFN, K_RMS_MIX1, K_SOFTMAX, K_FFNCONV, K_FFNFIX, K_LRU, K_LRUCONV, K_SCAN, K_FINAL };
enum { E_BF16 = 0, E_F32, E_RESID, E_GATE, E_SOFTMAX, E_FFN, E_DFT };

struct Unit { const char* A; const char* B; int pm, pn, z1, z2; };

__device__ __forceinline__ void epi_bf16(const f32x4 (&acc)[2][2][4][2], const Unit& u, char* Cb, unsigned cZ1, unsigned cZ2, int ldc, int gelu_pn, int wr, int wc, int fr, int fq) {
    bf16_t* base = (bf16_t*)(Cb + (size_t)u.z1 * cZ1 + (size_t)u.z2 * cZ2) + (long)(u.pm * BM + wr * 64 + fr) * ldc + u.pn * BM + wc * 32 + 8 * fq;
    const bool g = u.pn < gelu_pn;
#pragma unroll
    for (int ai = 0; ai < 2; ++ai)
#pragma unroll
        for (int m = 0; m < 4; ++m) { bf16_t* rowp = base + (long)(ai * HALF + m * 16) * ldc;
#pragma unroll
            for (int bj = 0; bj < 2; ++bj) { f32x4 v0 = acc[ai][bj][m][0], v1 = acc[ai][bj][m][1];
                if (g) {
                    const f32x2 a = gelu_tanh2((f32x2){v0[0], v0[1]}), b = gelu_tanh2((f32x2){v0[2], v0[3]}), c = gelu_tanh2((f32x2){v1[0], v1[1]}), d = gelu_tanh2((f32x2){v1[2], v1[3]});
                    v0 = (f32x4){a.x, a.y, b.x, b.y}; v1 = (f32x4){c.x, c.y, d.x, d.y}; }
                u32x4 w; w.x = cvt_pk_bf16(v0[0], v0[1]); w.y = cvt_pk_bf16(v0[2], v0[3]); w.z = cvt_pk_bf16(v1[0], v1[1]); w.w = cvt_pk_bf16(v1[2], v1[3]);
                *(u32x4*)(rowp + bj * HALF) = w; } }
}
__device__ __forceinline__ void epi_f32(const f32x4 (&acc)[2][2][4][2], const Unit& u, char* Cb, unsigned cZ1, unsigned cZ2, int ldc, int wr, int wc, int fr, int fq) {
    float* base = (float*)(Cb + (size_t)u.z1 * cZ1 + (size_t)u.z2 * cZ2) + (long)(u.pm * BM + wr * 64 + fr) * ldc + u.pn * BM + wc * 32 + 4 * fq;
#pragma unroll
    for (int ai = 0; ai < 2; ++ai)
#pragma unroll
        for (int m = 0; m < 4; ++m) { float* rowp = base + (long)(ai * HALF + m * 16) * ldc;
#pragma unroll
            for (int bj = 0; bj < 2; ++bj)
#pragma unroll
                for (int n = 0; n < 2; ++n) *(f32x4*)(rowp + bj * HALF + n * 16) = acc[ai][bj][m][n]; }
}
__device__ __forceinline__ void epi_resid(const f32x4 (&acc)[2][2][4][2], const Unit& u, char* Cb, int ldc, const float* bias, int wr, int wc, int fr, int fq) {
    const int col0 = u.pn * BM + wc * 32 + 8 * fq;
    bf16_t* base = (bf16_t*)Cb + (long)(u.pm * BM + wr * 64 + fr) * ldc + col0;
#pragma unroll
    for (int bj = 0; bj < 2; ++bj) {
        const f32x4 b0 = bias ? *(const f32x4*)(bias + col0 + bj * HALF) : (f32x4){0.f, 0.f, 0.f, 0.f};
        const f32x4 b1 = bias ? *(const f32x4*)(bias + col0 + bj * HALF + 4) : (f32x4){0.f, 0.f, 0.f, 0.f};
#pragma unroll
        for (int ai = 0; ai < 2; ++ai)
#pragma unroll
            for (int m = 0; m < 4; ++m) { u32x4* q = (u32x4*)(base + (long)(ai * HALF + m * 16) * ldc + bj * HALF);
                const u32x4 x = *q; const f32x4 a0 = acc[ai][bj][m][0], a1 = acc[ai][bj][m][1];
                u32x4 w;
                w.x = cvt_pk_bf16(bflo(x.x) + a0[0] + b0[0], bfhi(x.x) + a0[1] + b0[1]); w.y = cvt_pk_bf16(bflo(x.y) + a0[2] + b0[2], bfhi(x.y) + a0[3] + b0[3]);
                w.z = cvt_pk_bf16(bflo(x.z) + a1[0] + b1[0], bfhi(x.z) + a1[1] + b1[1]); w.w = cvt_pk_bf16(bflo(x.w) + a1[2] + b1[2], bfhi(x.w) + a1[3] + b1[3]);
                *q = w; } }
}

__device__ __forceinline__ void epi_softmax(const f32x4 (&acc)[2][2][4][2], const Unit& u, char* Cb, unsigned cZ1, unsigned cZ2, int ldc, LAS float* rs, int wr, int wc, int fr, int fq) {
#pragma unroll
    for (int ai = 0; ai < 2; ++ai)
#pragma unroll
        for (int m = 0; m < 4; ++m) { float s = 0.f;
#pragma unroll
            for (int bj = 0; bj < 2; ++bj)
#pragma unroll
                for (int n = 0; n < 2; ++n)
#pragma unroll
                    for (int j = 0; j < 4; ++j) s += __expf(acc[ai][bj][m][n][j]);
            s += __shfl_xor(s, 16, 64); s += __shfl_xor(s, 32, 64);
            if (fq == 0) rs[((wr * 128 + ai * 64 + m * 16 + fr) << 2) + wc] = s; }
    asm volatile("s_waitcnt lgkmcnt(0)" ::: "memory");
    __builtin_amdgcn_s_barrier();
    __builtin_amdgcn_sched_barrier(0);
    asm volatile("" : "+s"(ldc) :: "memory");
    bf16_t* base = (bf16_t*)(Cb + (size_t)u.z1 * cZ1 + (size_t)u.z2 * cZ2) + (long)(u.pm * BM + wr * 64 + fr) * ldc + u.pn * BM + wc * 32 + 8 * fq;
#pragma unroll
    for (int ai = 0; ai < 2; ++ai)
#pragma unroll
        for (int m = 0; m < 4; ++m) {
            const f32x4 t = *(const LAS f32x4*)&rs[(wr * 128 + ai * 64 + m * 16 + fr) << 2];
            const float lg = __logf(t[0] + t[1] + t[2] + t[3]);
            bf16_t* rowp = base + (long)(ai * HALF + m * 16) * ldc;
#pragma unroll
            for (int bj = 0; bj < 2; ++bj) { f32x4 v0, v1;
#pragma unroll
                for (int j = 0; j < 4; ++j) { v0[j] = __expf(acc[ai][bj][m][0][j] - lg); v1[j] = __expf(acc[ai][bj][m][1][j] - lg); }
                u32x4 w; w.x = cvt_pk_bf16(v0[0], v0[1]); w.y = cvt_pk_bf16(v0[2], v0[3]); w.z = cvt_pk_bf16(v1[0], v1[1]); w.w = cvt_pk_bf16(v1[2], v1[3]);
                *(u32x4*)(rowp + bj * HALF) = w; } }
}

__device__ __forceinline__ float dpp_ror1(float x) { return __builtin_bit_cast(float, __builtin_amdgcn_mov_dpp(__builtin_bit_cast(int, x), 0x121, 0xf, 0xf, true)); }
__device__ __forceinline__ float dpp_rol1(float x) { return __builtin_bit_cast(float, __builtin_amdgcn_mov_dpp(__builtin_bit_cast(int, x), 0x12F, 0xf, 0xf, true)); }
__device__ __forceinline__ void epi_ffn(const f32x4 (&acc)[2][2][4][2], const Unit& u, char* Cb, const float* __restrict__ cw, const float* __restrict__ cb, float* __restrict__ edge, long edgeN,
                                        LAS float* E, int wr, int wc, int fr, int fq) {
    const int cl = wc * 32 + 4 * fq;
#pragma unroll
    for (int ai = 0; ai < 2; ++ai)
#pragma unroll
        for (int n = 0; n < 2; ++n) {
            if (fr == 0)  *(LAS f32x4*)&E[((wr * 2 + ai) * 2 + 0) * 128 + cl + 16 * n] = acc[ai][0][0][n];
            if (fr == 15) *(LAS f32x4*)&E[((wr * 2 + ai) * 2 + 1) * 128 + cl + 16 * n] = acc[ai][0][3][n];
        }
    asm volatile("s_waitcnt lgkmcnt(0)" ::: "memory");
    __builtin_amdgcn_s_barrier();
    __builtin_amdgcn_s_barrier();
    __builtin_amdgcn_sched_barrier(0);
    const int f0 = u.pn * 128 + cl;
    bf16_t* hbase = (bf16_t*)Cb + (long)(u.pm * BM + wr * 64 + fr) * DFF + f0;
#pragma unroll
    for (int n = 0; n < 2; ++n) {
        const f32x4 w0 = *(const f32x4*)(cw + f0 + 16 * n), w1 = *(const f32x4*)(cw + DFF + f0 + 16 * n), w2 = *(const f32x4*)(cw + 2 * DFF + f0 + 16 * n), bb = *(const f32x4*)(cb + f0 + 16 * n);
#pragma unroll
        for (int ai = 0; ai < 2; ++ai) {
            const f32x4 zero = {0.f, 0.f, 0.f, 0.f};
            f32x4 bup, bdn;
            if (wr == 1) bup = *(const LAS f32x4*)&E[((0 * 2 + ai) * 2 + 1) * 128 + cl + 16 * n];
            else if (ai == 1) bup = *(const LAS f32x4*)&E[((1 * 2 + 0) * 2 + 1) * 128 + cl + 16 * n];
            else bup = zero;
            if (wr == 0) bdn = *(const LAS f32x4*)&E[((1 * 2 + ai) * 2 + 0) * 128 + cl + 16 * n];
            else if (ai == 0) bdn = *(const LAS f32x4*)&E[((0 * 2 + 1) * 2 + 0) * 128 + cl + 16 * n];
            else bdn = zero;
            f32x4 r1[4], l1[4];
#pragma unroll
            for (int m = 0; m < 4; ++m)
#pragma unroll
                for (int j = 0; j < 4; ++j) { r1[m][j] = dpp_ror1(acc[ai][0][m][n][j]); l1[m][j] = dpp_rol1(acc[ai][0][m][n][j]); }
#pragma unroll
            for (int m = 0; m < 4; ++m) {
                const f32x4 g = acc[ai][0][m][n], v = acc[ai][1][m][n];
                const f32x4 upw = (m > 0) ? r1[m > 0 ? m - 1 : 0] : bup, dnw = (m < 3) ? l1[m < 3 ? m + 1 : 3] : bdn;
                f32x4 cv; float o[4];
#pragma unroll
                for (int jp = 0; jp < 2; ++jp) {
                    f32x2 up2, dn2;
                    up2.x = (fr == 0) ? upw[2 * jp] : r1[m][2 * jp]; up2.y = (fr == 0) ? upw[2 * jp + 1] : r1[m][2 * jp + 1];
                    dn2.x = (fr == 15) ? dnw[2 * jp] : l1[m][2 * jp]; dn2.y = (fr == 15) ? dnw[2 * jp + 1] : l1[m][2 * jp + 1];
                    const f32x2 g2 = {g[2 * jp], g[2 * jp + 1]}, v2 = {v[2 * jp], v[2 * jp + 1]};
                    const f32x2 w0p = {w0[2 * jp], w0[2 * jp + 1]}, w1p = {w1[2 * jp], w1[2 * jp + 1]}, w2p = {w2[2 * jp], w2[2 * jp + 1]}, bbp = {bb[2 * jp], bb[2 * jp + 1]};
                    const f32x2 c2 = w0p * up2 + (w1p * g2 + (w2p * dn2 + bbp));
                    const f32x2 o2 = gelu_tanh2(c2) * v2;
                    cv[2 * jp] = c2.x; cv[2 * jp + 1] = c2.y; o[2 * jp] = o2.x; o[2 * jp + 1] = o2.y;
                }
                u32x2 w; w.x = cvt_pk_bf16(o[0], o[1]); w.y = cvt_pk_bf16(o[2], o[3]);
                *(u32x2*)(hbase + (long)(ai * HALF + m * 16) * DFF + 16 * n) = w;
                if (ai == 0 && m == 0 && wr == 0 && fr == 0) {
                    float* e0 = edge + ((long)u.pm * 2 + 0) * DFF + f0 + 16 * n;
                    *(f32x4*)e0 = g; *(f32x4*)(e0 + edgeN) = cv; *(f32x4*)(e0 + 2 * edgeN) = v; }
                if (ai == 1 && m == 3 && wr == 1 && fr == 15) {
                    float* e1 = edge + ((long)u.pm * 2 + 1) * DFF + f0 + 16 * n;
                    *(f32x4*)e1 = g; *(f32x4*)(e1 + edgeN) = cv; *(f32x4*)(e1 + 2 * edgeN) = v; }
            }
        }
    }
}

__device__ __forceinline__ void epi_dft(const f32x4 (&acc)[2][2][4][2], const Unit& u, char* Cb, unsigned cZ1, int wr, int wc, int fr, int fq) {
    asm volatile("" : "+v"(fq), "+v"(fr));
    bf16_t* fb = (bf16_t*)(Cb + (size_t)u.z1 * cZ1) + u.pn * BM;
    const int r0 = u.pm * BM + wr * 64 + fr;
#pragma unroll
    for (int ai = 0; ai < 2; ++ai)
#pragma unroll
        for (int m = 0; m < 4; ++m) {
            const int s = r0 + ai * HALF + m * 16;
            bf16_t* rowp = fb + (long)s * DM;
            bf16_t* mir = fb + (long)(SEQ - s) * DM;
#pragma unroll
            for (int bj = 0; bj < 2; ++bj) {
                const int c0 = bj * HALF + wc * 32 + 8 * fq;
                const f32x4 v0 = acc[ai][bj][m][0], v1 = acc[ai][bj][m][1];
                u32x4 w; w.x = cvt_pk_bf16(v0[0], v0[1]); w.y = cvt_pk_bf16(v0[2], v0[3]); w.z = cvt_pk_bf16(v1[0], v1[1]); w.w = cvt_pk_bf16(v1[2], v1[3]);
                *(u32x4*)(rowp + c0) = w;
                if (s != 0) {
                    bf16_t* mg = mir + (248 - c0);
                    mg[1] = (bf16_t)(w.w >> 16);
                    *(unsigned*)(mg + 2) = cvt_pk_bf16(v1[2], v1[1]);
                    u32x2 t; t.x = cvt_pk_bf16(v1[0], v0[3]); t.y = cvt_pk_bf16(v0[2], v0[1]);
                    *(u32x2*)(mg + 4) = t;
                    mir[(256 - c0) & 255] = (bf16_t)(w.x & 0xffffu);
                }
            }
        }
}
__device__ __forceinline__ void epi_gate(const f32x4 (&acc)[2][2][4][2], const Unit& u, const bf16_t* cbuf, unsigned* LB, const float* b_a, const float* b_i, const float* c8sp, long Tc,
                                         int wr, int wc, int fr, int fq) {
    const int e = u.z1, h = u.z2;
#pragma unroll
    for (int n = 0; n < 2; ++n) {
        const int ch = h * 128 + wc * 32 + 8 * fq + 4 * n;
        const f32x4 ba = *(const f32x4*)(b_a + e * DRNN + ch), bi = *(const f32x4*)(b_i + e * DRNN + ch), sp = *(const f32x4*)(c8sp + e * DRNN + ch);
#pragma unroll
        for (int ai = 0; ai < 2; ++ai)
#pragma unroll
            for (int m = 0; m < 4; ++m) {
                const long row = (long)u.pm * BM + ai * HALF + wr * 64 + m * 16 + fr;
                const u32x2 cw = *(const u32x2*)(cbuf + row * DRNN + ch);
                const float cv[4] = {bflo(cw.x), bfhi(cw.x), bflo(cw.y), bfhi(cw.y)};
                u32x4 w;
#pragma unroll
                for (int j = 0; j < 4; ++j) {
                    const float r = sigmoidf(acc[ai][0][m][n][j] + ba[j]);
                    const float ig = sigmoidf(acc[ai][1][m][n][j] + bi[j]);
                    const float la = -sp[j] * r;
                    const float a2 = __expf(2.0f * la);
                    w[j] = cvt_pk_bf16(la, __builtin_sqrtf(fmaxf(1.0f - a2, 0.f)) * ig * cv[j]);
                }
                *(u32x4*)(LB + ((long)e * Tc + row) * DRNN + ch) = w;
            }
    }
}

__device__ __forceinline__ void gemm_phase(const int bid, const int nblk, LAS unsigned char* lds, const int garg, const int chunk, const Params& p) {
    const GemmDesc& d = p.g[garg];
    const int tid = tid_(), wid = __builtin_amdgcn_readfirstlane(tid >> 6), lane = tid & 63, wr = wid >> 2, wc = wid & 3, fr = lane & 15, fq = lane >> 4;
    const int K = d.K, lda = d.lda, ldb = d.ldb, epi = d.epi, nt = K / BK;
    const int nM = d.nM, nN = d.nN, zdiv = d.zdiv, nwg = nM * nN * d.nZ;
    const char* Ab = d.A + (size_t)chunk * d.aCh; const char* Bb = d.B + (size_t)chunk * d.bCh;
    const unsigned aZ1 = d.aZ1, aZ2 = d.aZ2, bZ1 = d.bZ1, bZ2 = d.bZ2, aTile = d.aTile, bTile = d.bTile;
    const unsigned mper = d.mper, mnig = d.mnig, mgsz = d.mgsz, mzdiv = d.mzdiv; const bool rev = d.padm != 0u;
    const int per = nM * nN, nig = 8 * nN, gsz = nM < 8 ? nM : 8, q8 = nwg >> 3, r8 = nwg & 7;
    auto next = [&](int i, Unit& u) -> bool {
        const long L = (long)i * nblk + bid; if (L >= nwg) return false;
        int w = (int)L; { const int xcd = w & 7; int off = w >> 3; const int cntx = xcd < r8 ? q8 + 1 : q8;
            if (rev) off = cntx - 1 - off;
            w = (xcd < r8 ? xcd * (q8 + 1) : r8 * (q8 + 1) + (xcd - r8) * q8) + off; }
        const int z = (int)__umulhi((unsigned)w, mper), loc = w - z * per;
        const int gid = (int)__umulhi((unsigned)loc, mnig), lr = loc - gid * nig;
        const int pn = (int)__umulhi((unsigned)lr, mgsz), pm = gid * 8 + lr - pn * gsz;
        const int z1 = zdiv == 1 ? z : (int)__umulhi((unsigned)z, mzdiv), z2 = z - z1 * zdiv;
        u.A = Ab + (size_t)z1 * aZ1 + (size_t)z2 * aZ2 + (size_t)pm * aTile; u.B = Bb + (size_t)z1 * bZ1 + (size_t)z2 * bZ2 + (size_t)pn * bTile;
        u.pm = pm; u.pn = pn; u.z1 = z1; u.z2 = z2; return true;
    };
    unsigned voffA[2], voffB[2];
#pragma unroll
    for (int i = 0; i < 2; ++i) { int R, C; stage_rc(tid * 16 + i * 8192, R, C); const int Rb = (epi != E_F32 && epi != E_FFN) ? ((R & ~31) + perm32(R & 31)) : R;
        voffA[i] = (unsigned)(R * lda + C) * 2u; voffB[i] = (unsigned)(Rb * ldb + C) * 2u; }
    const size_t kstep = (size_t)(BK * 2);
    const size_t hstepA = (size_t)HALF * lda * 2, hstepB = (size_t)d.bhalf * ldb * 2;
    const unsigned ldsw = (unsigned)wid * 1024u;
    const int aoff = lds_byte(wr * 64 + fr, fq * 8), boff = lds_byte(wc * 32 + fr, fq * 8);
#define PG8_SA(b, h) (((b) * 2 + (h)) * HTB)
#define PG8_SB(b, h) ((4 + (b) * 2 + (h)) * HTB)
#define PG8_STAGE(bufoff, gbase, voff) do { _Pragma("unroll") for (int _i = 0; _i < 2; ++_i) \
        __builtin_amdgcn_global_load_lds((const unsigned*)((const char*)(gbase) + (voff)[_i]), (LAS unsigned*)(lds + (bufoff) + ldsw + _i * 8192), 16, 0, 0); } while (0)
#define PG8_LDA(dst, b, h) do { _Pragma("unroll") for (int m = 0; m < 4; ++m) _Pragma("unroll") for (int k = 0; k < 2; ++k) dst[m][k] = *(const LAS bf16x8*)(lds + PG8_SA(b, h) + aoff + m * 2048 + k * 1024); } while (0)
#define PG8_LDB(dst, b, h) do { _Pragma("unroll") for (int n = 0; n < 2; ++n) _Pragma("unroll") for (int k = 0; k < 2; ++k) dst[n][k] = *(const LAS bf16x8*)(lds + PG8_SB(b, h) + boff + n * 2048 + k * 1024); } while (0)
#define PG8_MMA(ai, bj, At, Bt) do { __builtin_amdgcn_s_setprio(1); _Pragma("unroll") for (int m = 0; m < 4; ++m) _Pragma("unroll") for (int n = 0; n < 2; ++n) _Pragma("unroll") for (int k = 0; k < 2; ++k) \
        acc[ai][bj][m][n] = __builtin_amdgcn_mfma_f32_16x16x32_bf16(Bt[n][k], At[m][k], acc[ai][bj][m][n], 0, 0, 0); __builtin_amdgcn_s_setprio(0); } while (0)
#define PG8_WAIT_V(n) asm volatile("s_waitcnt vmcnt(" #n ")" ::: "memory")
#define PG8_WAIT_L(n) asm volatile("s_waitcnt lgkmcnt(" #n ")" ::: "memory")
#define PG8_BAR __builtin_amdgcn_s_barrier()
#define PG8_SCHED __builtin_amdgcn_sched_barrier(0)
    Unit cur, nxt; int ui = 0;
    if (!next(0, cur)) return;
    f32x4 acc[2][2][4][2];
#pragma unroll
    for (int a = 0; a < 2; ++a)
#pragma unroll
        for (int b = 0; b < 2; ++b)
#pragma unroll
            for (int m = 0; m < 4; ++m)
#pragma unroll
                for (int n = 0; n < 2; ++n) acc[a][b][m][n] = (f32x4){0.f, 0.f, 0.f, 0.f};
    bf16x8 At[4][2], B0[2][2], B1[2][2];
    const char* cA = cur.A; const char* cB = cur.B;
    PG8_STAGE(PG8_SB(0, 0), cB, voffB); PG8_STAGE(PG8_SA(0, 0), cA, voffA); PG8_STAGE(PG8_SB(0, 1), cB + hstepB, voffB); PG8_STAGE(PG8_SA(0, 1), cA + hstepA, voffA);
    if (wr == 1) PG8_BAR;
    PG8_WAIT_V(4); PG8_BAR;
    PG8_STAGE(PG8_SB(1, 0), cB + kstep, voffB); PG8_STAGE(PG8_SA(1, 0), cA + kstep, voffA); PG8_STAGE(PG8_SB(1, 1), cB + hstepB + kstep, voffB);
    PG8_WAIT_V(6); PG8_BAR;
    for (;;) {
        const bool has_next = next(ui + 1, nxt);
        const char* nA = has_next ? nxt.A : cA; const char* nB = has_next ? nxt.B : cB;
        for (int t = 0; t < nt; t += 2) {
            const bool last = (t == nt - 2);
            const char* a1 = cA + (size_t)(t + 1) * kstep;
            const char* a2 = last ? nA : cA + (size_t)(t + 2) * kstep; const char* b2 = last ? nB : cB + (size_t)(t + 2) * kstep;
            const char* a3 = a2 + kstep; const char* b3 = b2 + kstep;
            PG8_LDB(B0, 0, 0); PG8_SCHED; PG8_LDA(At, 0, 0); PG8_STAGE(PG8_SA(1, 1), a1 + hstepA, voffA);
            PG8_WAIT_L(8); PG8_BAR; PG8_WAIT_L(0); PG8_MMA(0, 0, At, B0); PG8_BAR; PG8_SCHED;
            PG8_LDB(B1, 0, 1); PG8_STAGE(PG8_SB(0, 0), b2, voffB);
            PG8_BAR; PG8_WAIT_L(0); PG8_MMA(0, 1, At, B1); PG8_BAR;
            PG8_LDA(At, 0, 1); PG8_STAGE(PG8_SA(0, 0), a2, voffA);
            PG8_BAR; PG8_WAIT_L(0); PG8_MMA(1, 0, At, B0); PG8_BAR; PG8_SCHED;
            PG8_STAGE(PG8_SB(0, 1), b2 + hstepB, voffB);
            PG8_WAIT_V(6); PG8_BAR; PG8_MMA(1, 1, At, B1); PG8_BAR;
            PG8_LDB(B0, 1, 0); PG8_SCHED; PG8_LDA(At, 1, 0); PG8_STAGE(PG8_SA(0, 1), a2 + hstepA, voffA);
            PG8_WAIT_L(8); PG8_BAR; PG8_WAIT_L(0); PG8_MMA(0, 0, At, B0); PG8_BAR; PG8_SCHED;
            PG8_LDB(B1, 1, 1); PG8_STAGE(PG8_SB(1, 0), b3, voffB);
            PG8_BAR; PG8_WAIT_L(0); PG8_MMA(0, 1, At, B1); PG8_BAR;
            PG8_LDA(At, 1, 1); PG8_STAGE(PG8_SA(1, 0), a3, voffA);
            PG8_BAR; PG8_WAIT_L(0); PG8_MMA(1, 0, At, B0); PG8_BAR; PG8_SCHED;
            PG8_STAGE(PG8_SB(1, 1), b3 + hstepB, voffB);
            PG8_WAIT_V(6); PG8_BAR; PG8_MMA(1, 1, At, B1); PG8_BAR;
        }
        {
            int zE; asm volatile("s_mov_b32 %0, 0" : "=s"(zE));
            const GemmDesc& de = p.g[garg + zE];
            char* Cb = de.C + (size_t)chunk * de.cCh;
            if (epi == E_BF16) epi_bf16(acc, cur, Cb, de.cZ1, de.cZ2, de.ldc, de.gelu_pn, wr, wc, fr, fq);
            else if (epi == E_RESID) epi_resid(acc, cur, Cb, de.ldc, de.bias, wr, wc, fr, fq);
            else if (epi == E_F32) epi_f32(acc, cur, Cb, de.cZ1, de.cZ2, de.ldc, wr, wc, fr, fq);
            else if (epi == E_DFT) epi_dft(acc, cur, Cb, de.cZ1, wr, wc, fr, fq);
            else if (epi == E_FFN) { const int layer = de.gelu_pn; epi_ffn(acc, cur, Cb, p.in[23 + zE] + layer * 3 * DFF, p.in[24 + zE] + layer * DFF, p.edge + zE, (long)de.nM * 2 * DFF, (LAS float*)(lds + STAGE_BYTES), wr, wc, fr, fq); }
            else if (epi == E_SOFTMAX) epi_softmax(acc, cur, Cb, de.cZ1, de.cZ2, de.ldc, (LAS float*)(lds + STAGE_BYTES), wr, wc, fr, fq);
            else { const long Tc = (long)(p.CB + zE) * SEQ; epi_gate(acc, cur, (const bf16_t*)(de.A + (size_t)chunk * de.aCh), (unsigned*)Cb, p.in[11 + zE], p.in[13 + zE], p.c8sp + zE, Tc, wr, wc, fr, fq); }
        }
        if (!has_next) break;
#pragma unroll
        for (int a = 0; a < 2; ++a)
#pragma unroll
            for (int b = 0; b < 2; ++b)
#pragma unroll
                for (int m = 0; m < 4; ++m)
#pragma unroll
                    for (int n = 0; n < 2; ++n) acc[a][b][m][n] = (f32x4){0.f, 0.f, 0.f, 0.f};
        cur = nxt; cA = nA; cB = nB; ++ui;
    }
    PG8_WAIT_V(0);
    if (wr == 0) PG8_BAR;
    PG8_BAR;
#undef PG8_SA
#undef PG8_SB
#undef PG8_STAGE
#undef PG8_LDA
#undef PG8_LDB
#undef PG8_MMA
#undef PG8_WAIT_V
#undef PG8_WAIT_L
#undef PG8_BAR
#undef PG8_SCHED
}

__device__ void transpose_job(const int bid, const int nblk, float* tile, const float* __restrict__ src, bf16_t* __restrict__ dst, int K, int N, int nb, long dstB, float scale) {
    const int tk = K / 64, tn = N / 64, per = tk * tn, tot = per * nb, tid = tid_();
    const int kk = tid >> 6, nn = tid & 63;
    float r[8];
    int t = bid;
    if (t < tot) { const int b = t / per, l = t - b * per, k0 = (l / tn) * 64, n0 = (l % tn) * 64; const float* s = src + (long)b * K * N;
#pragma unroll
        for (int i = 0; i < 8; ++i) r[i] = s[(long)(k0 + kk + 8 * i) * N + n0 + nn]; }
    while (t < tot) {
        const int b = t / per, l = t - b * per, k0 = (l / tn) * 64, n0 = (l % tn) * 64;
        bf16_t* d = dst + (long)b * dstB;
#pragma unroll
        for (int i = 0; i < 8; ++i) tile[(kk + 8 * i) * 65 + nn] = r[i];
        __syncthreads();
        const int t2 = t + nblk;
        if (t2 < tot) { const int b2 = t2 / per, l2 = t2 - b2 * per, k2 = (l2 / tn) * 64, n2 = (l2 % tn) * 64; const float* s2 = src + (long)b2 * K * N;
#pragma unroll
            for (int i = 0; i < 8; ++i) r[i] = s2[(long)(k2 + kk + 8 * i) * N + n2 + nn]; }
#pragma unroll
        for (int i = 0; i < 8; ++i) { const int n = kk + 8 * i, k = nn; d[(long)(n0 + n) * K + k0 + k] = f2bf(tile[k * 65 + n] * scale); }
        __syncthreads();
        t = t2;
    }
}

__device__ __forceinline__ float wave_sum(float v) {
#pragma unroll
    for (int o = 32; o > 0; o >>= 1) v += __shfl_xor(v, o, 64);
    return v;
}
__device__ __forceinline__ float wave_max(float v) {
#pragma unroll
    for (int o = 32; o > 0; o >>= 1) v = fmaxf(v, __shfl_xor(v, o, 64));
    return v;
}

__device__ void rms_phase(const int bid, const int nblk, long g0, long nrows, const float* __restrict__ src0, const float* __restrict__ src1, long split, const float* __restrict__ gain,
                          bf16_t* __restrict__ dst, bf16_t* __restrict__ cpy) {
    const int wid = tid_() >> 6, lane = tid_() & 63;
    f32x4 gv[4];
#pragma unroll
    for (int i = 0; i < 4; ++i) gv[i] = *(const f32x4*)(gain + i * 256 + lane * 4);
    const long stride = (long)nblk * 8;
    for (long r = (long)bid * 8 + wid; r < nrows; r += 2 * stride) {
        const long rr[2] = {r, r + stride};
        f32x4 v[2][4];
#pragma unroll
        for (int q = 0; q < 2; ++q) if (rr[q] < nrows) {
            const long gr = g0 + rr[q];
            const float* s = gr < split ? src0 + gr * DM : src1 + (gr - split) * DM;
#pragma unroll
            for (int i = 0; i < 4; ++i) v[q][i] = *(const f32x4*)(s + i * 256 + lane * 4);
        }
#pragma unroll
        for (int q = 0; q < 2; ++q) if (rr[q] < nrows) {
            float ss = 0.f;
#pragma unroll
            for (int i = 0; i < 4; ++i) ss += v[q][i][0] * v[q][i][0] + v[q][i][1] * v[q][i][1] + v[q][i][2] * v[q][i][2] + v[q][i][3] * v[q][i][3];
            ss = wave_sum(ss);
            const float rs = rsqrtf(ss * (1.0f / DM) + 1e-6f);
#pragma unroll
            for (int i = 0; i < 4; ++i) {
                u32x2 w; w.x = cvt_pk_bf16(v[q][i][0] * rs * gv[i][0], v[q][i][1] * rs * gv[i][1]); w.y = cvt_pk_bf16(v[q][i][2] * rs * gv[i][2], v[q][i][3] * rs * gv[i][3]);
                *(u32x2*)(dst + rr[q] * DM + i * 256 + lane * 4) = w;
                if (cpy) { u32x2 c; c.x = cvt_pk_bf16(v[q][i][0], v[q][i][1]); c.y = cvt_pk_bf16(v[q][i][2], v[q][i][3]); *(u32x2*)(cpy + rr[q] * DM + i * 256 + lane * 4) = c; }
            }
        }
    }
}
__device__ void rms_bf_phase(const int bid, const int nblk, long nrows, const bf16_t* __restrict__ X, const float* __restrict__ gain, bf16_t* __restrict__ dst) {
    const int wid = tid_() >> 6, lane = tid_() & 63;
    f32x4 gv[4];
#pragma unroll
    for (int i = 0; i < 2; ++i) { gv[2 * i] = *(const f32x4*)(gain + i * 512 + lane * 8); gv[2 * i + 1] = *(const f32x4*)(gain + i * 512 + lane * 8 + 4); }
    const long stride = (long)nblk * 8;
    for (long r = (long)bid * 8 + wid; r < nrows; r += 2 * stride) {
        const long rr[2] = {r, r + stride};
        u32x4 v[2][2];
#pragma unroll
        for (int q = 0; q < 2; ++q) if (rr[q] < nrows) {
#pragma unroll
            for (int i = 0; i < 2; ++i) v[q][i] = *(const u32x4*)(X + rr[q] * DM + i * 512 + lane * 8);
        }
#pragma unroll
        for (int q = 0; q < 2; ++q) if (rr[q] < nrows) {
            float f[16]; float ss = 0.f;
#pragma unroll
            for (int i = 0; i < 2; ++i)
#pragma unroll
                for (int k = 0; k < 4; ++k) { f[i * 8 + 2 * k] = bflo(v[q][i][k]); f[i * 8 + 2 * k + 1] = bfhi(v[q][i][k]); }
#pragma unroll
            for (int k = 0; k < 16; ++k) ss += f[k] * f[k];
            ss = wave_sum(ss);
            const float rs = rsqrtf(ss * (1.0f / DM) + 1e-6f);
#pragma unroll
            for (int i = 0; i < 2; ++i) {
                u32x4 w;
                w.x = cvt_pk_bf16(f[i * 8 + 0] * rs * gv[2 * i][0], f[i * 8 + 1] * rs * gv[2 * i][1]); w.y = cvt_pk_bf16(f[i * 8 + 2] * rs * gv[2 * i][2], f[i * 8 + 3] * rs * gv[2 * i][3]);
                w.z = cvt_pk_bf16(f[i * 8 + 4] * rs * gv[2 * i + 1][0], f[i * 8 + 5] * rs * gv[2 * i + 1][1]); w.w = cvt_pk_bf16(f[i * 8 + 6] * rs * gv[2 * i + 1][2], f[i * 8 + 7] * rs * gv[2 * i + 1][3]);
                *(u32x4*)(dst + rr[q] * DM + i * 512 + lane * 8) = w;
            }
        }
    }
}
__device__ void final_norm_phase(const int bid, const int nblk, const bf16_t* __restrict__ X, float* __restrict__ y, long nrows, const float* __restrict__ gain) {
    const int wid = tid_() >> 6, lane = tid_() & 63;
    f32x4 gv[4];
#pragma unroll
    for (int i = 0; i < 2; ++i) { gv[2 * i] = *(const f32x4*)(gain + i * 512 + lane * 8); gv[2 * i + 1] = *(const f32x4*)(gain + i * 512 + lane * 8 + 4); }
    for (long r = (long)bid * 8 + wid; r < nrows; r += (long)nblk * 8) {
        u32x4 v[2];
#pragma unroll
        for (int i = 0; i < 2; ++i) v[i] = *(const u32x4*)(X + r * DM + i * 512 + lane * 8);
        float f[16]; float ss = 0.f;
#pragma unroll
        for (int i = 0; i < 2; ++i)
#pragma unroll
            for (int k = 0; k < 4; ++k) { f[i * 8 + 2 * k] = bflo(v[i][k]); f[i * 8 + 2 * k + 1] = bfhi(v[i][k]); }
#pragma unroll
        for (int k = 0; k < 16; ++k) ss += f[k] * f[k];
        ss = wave_sum(ss);
        const float rs = rsqrtf(ss * (1.0f / DM) + 1e-6f);
#pragma unroll
        for (int i = 0; i < 2; ++i) {
            f32x4 o0, o1;
#pragma unroll
            for (int j = 0; j < 4; ++j) { o0[j] = f[i * 8 + j] * rs * gv[2 * i][j]; o1[j] = f[i * 8 + 4 + j] * rs * gv[2 * i + 1][j]; }
            *(f32x4*)(y + r * DM + i * 512 + lane * 8) = o0; *(f32x4*)(y + r * DM + i * 512 + lane * 8 + 4) = o1;
        }
    }
}
__device__ void dft_row1024_job(const int bid, const int nblk, const bf16_t* __restrict__ YT, bf16_t* __restrict__ F, int CB) {
    const int wid = tid_() >> 6, lane = tid_() & 63;
    const int nrow = CB * DM;
    for (int r = bid * 8 + wid; r < nrow; r += nblk * 8) {
        const bf16_t* y = YT + (long)r * (2 * SEQ) + lane * 8;
        float s = 0.f;
#pragma unroll
        for (int i = 0; i < 4; ++i) { const u32x4 w = *(const u32x4*)(y + i * 512);
#pragma unroll
            for (int k = 0; k < 4; ++k) s += bflo(w[k]) - bfhi(w[k]); }
        s = wave_sum(s);
        if (lane == 0) { const int bi = r >> 10, gc = r & 1023; F[((long)bi * SEQ + 1024) * DM + gc] = f2bf(s * 0.022097086912f); }
    }
}
__device__ void softmax_phase(const int bid, const int nblk, const float* __restrict__ S, bf16_t* __restrict__ P, long nrh) {
    const int wid = tid_() >> 6, lane = tid_() & 63;
    for (long r = (long)bid * 8 + wid; r < nrh; r += (long)nblk * 8) {
        f32x4 v = *(const f32x4*)(S + r * 256 + lane * 4);
        float mx = wave_max(fmaxf(fmaxf(v[0], v[1]), fmaxf(v[2], v[3])));
        f32x4 e; for (int j = 0; j < 4; ++j) e[j] = __expf(v[j] - mx);
        const float inv = 1.0f / wave_sum(e[0] + e[1] + e[2] + e[3]);
        u32x2 w; w.x = cvt_pk_bf16(e[0] * inv, e[1] * inv); w.y = cvt_pk_bf16(e[2] * inv, e[3] * inv);
        *(u32x2*)(P + r * 256 + lane * 4) = w;
    }
}
__device__ void ffn_conv_phase(const int bid, const int nblk, bf16_t* __restrict__ GV, long Tc, const float* __restrict__ cw, const float* __restrict__ cb) {
    const long tot = (Tc / 4) * (DFF / 8);
    for (long i = (long)bid * 512 + tid_(); i < tot; i += (long)nblk * 512) {
        const long t4 = i / (DFF / 8); const int f = (int)(i - t4 * (DFF / 8)) * 8; const long t = t4 * 4; const int pos = (int)(t & (SEQ - 1));
        bf16_t* g = GV + t * (2 * DFF) + f;
        const u32x4 z = {0u, 0u, 0u, 0u};
        u32x4 gr[6], vr[4];
        gr[0] = pos > 0 ? *(const u32x4*)(g - 2 * DFF) : z;
#pragma unroll
        for (int q = 0; q < 4; ++q) { gr[q + 1] = *(const u32x4*)(g + (long)q * 2 * DFF); vr[q] = *(const u32x4*)(g + (long)q * 2 * DFF + DFF); }
        gr[5] = pos + 4 < SEQ ? *(const u32x4*)(g + (long)4 * 2 * DFF) : z;
        float w0[8], w1[8], w2[8], bb[8];
#pragma unroll
        for (int j = 0; j < 8; ++j) { w0[j] = cw[f + j]; w1[j] = cw[DFF + f + j]; w2[j] = cw[2 * DFF + f + j]; bb[j] = cb[f + j]; }
#pragma unroll
        for (int q = 0; q < 4; ++q) {
            float o[8];
#pragma unroll
            for (int j = 0; j < 8; ++j) {
                const unsigned a0 = gr[q][j >> 1], a1 = gr[q + 1][j >> 1], a2 = gr[q + 2][j >> 1], av = vr[q][j >> 1];
                const float x0 = (j & 1) ? bfhi(a0) : bflo(a0), x1 = (j & 1) ? bfhi(a1) : bflo(a1), x2 = (j & 1) ? bfhi(a2) : bflo(a2), xv = (j & 1) ? bfhi(av) : bflo(av);
                o[j] = gelu_tanh(x0 * w0[j] + x1 * w1[j] + x2 * w2[j] + bb[j]) * xv;
            }
            u32x4 w; w.x = cvt_pk_bf16(o[0], o[1]); w.y = cvt_pk_bf16(o[2], o[3]); w.z = cvt_pk_bf16(o[4], o[5]); w.w = cvt_pk_bf16(o[6], o[7]);
            *(u32x4*)(g + (long)q * 2 * DFF + DFF) = w;
        }
    }
}
__device__ void ffn_fix_phase(const int bid, const int nblk, bf16_t* __restrict__ H, int nMt, const float* __restrict__ edge, const float* __restrict__ cw) {
    const long edgeN = (long)nMt * 2 * DFF; const long tot = (long)nMt * 2 * (DFF / 4);
    for (long i = (long)bid * 512 + tid_(); i < tot; i += (long)nblk * 512) {
        const int pm = (int)(i / (2 * (DFF / 4))); const int rem = (int)(i - (long)pm * (2 * (DFF / 4))); const int e = rem / (DFF / 4), f = (rem - e * (DFF / 4)) * 4;
        const int sp = pm & 7;
        if ((e == 0 && sp == 0) || (e == 1 && sp == 7)) continue;
        const float* me = edge + ((long)pm * 2 + e) * DFF + f;
        const f32x4 part = *(const f32x4*)(me + edgeN), v = *(const f32x4*)(me + 2 * edgeN);
        const f32x4 gn = e == 0 ? *(const f32x4*)(edge + ((long)(pm - 1) * 2 + 1) * DFF + f) : *(const f32x4*)(edge + ((long)(pm + 1) * 2 + 0) * DFF + f);
        const f32x4 w = *(const f32x4*)(cw + (e == 0 ? 0 : 2 * DFF) + f);
        float o[4];
#pragma unroll
        for (int j = 0; j < 4; ++j) o[j] = gelu_tanh(part[j] + w[j] * gn[j]) * v[j];
        u32x2 ww; ww.x = cvt_pk_bf16(o[0], o[1]); ww.y = cvt_pk_bf16(o[2], o[3]);
        *(u32x2*)(H + ((long)pm * BM + (e == 0 ? 0 : 255)) * DFF + f) = ww;
    }
}
__device__ void lru_conv_phase(const int bid, const int nblk, const bf16_t* __restrict__ U, bf16_t* __restrict__ cbuf, long Tc, const float* __restrict__ cw, const float* __restrict__ cb) {
    const long tot = (Tc / 4) * (DRNN / 8);
    for (long i = (long)bid * 512 + tid_(); i < tot; i += (long)nblk * 512) {
        const long t4 = i / (DRNN / 8); const int f = (int)(i - t4 * (DRNN / 8)) * 8; const long t = t4 * 4; const int pos = (int)(t & (SEQ - 1));
        const bf16_t* g = U + t * (2 * DRNN) + DRNN + f;
        const u32x4 z = {0u, 0u, 0u, 0u};
        u32x4 rr[7];
        rr[0] = pos > 1 ? *(const u32x4*)(g - 4 * DRNN) : z; rr[1] = pos > 0 ? *(const u32x4*)(g - 2 * DRNN) : z;
#pragma unroll
        for (int q = 0; q < 4; ++q) rr[q + 2] = *(const u32x4*)(g + (long)q * 2 * DRNN);
        rr[6] = pos + 4 < SEQ ? *(const u32x4*)(g + (long)4 * 2 * DRNN) : z;
        float w0[8], w1[8], w2[8], w3[8], bb[8];
#pragma unroll
        for (int j = 0; j < 8; ++j) { w0[j] = cw[f + j]; w1[j] = cw[DRNN + f + j]; w2[j] = cw[2 * DRNN + f + j]; w3[j] = cw[3 * DRNN + f + j]; bb[j] = cb[f + j]; }
#pragma unroll
        for (int q = 0; q < 4; ++q) {
            float o[8];
#pragma unroll
            for (int j = 0; j < 8; ++j) {
                const unsigned a0 = rr[q][j >> 1], a1 = rr[q + 1][j >> 1], a2 = rr[q + 2][j >> 1], a3 = rr[q + 3][j >> 1];
                const float x0 = (j & 1) ? bfhi(a0) : bflo(a0), x1 = (j & 1) ? bfhi(a1) : bflo(a1), x2 = (j & 1) ? bfhi(a2) : bflo(a2), x3 = (j & 1) ? bfhi(a3) : bflo(a3);
                o[j] = x0 * w0[j] + x1 * w1[j] + x2 * w2[j] + x3 * w3[j] + bb[j];
            }
            u32x4 w; w.x = cvt_pk_bf16(o[0], o[1]); w.y = cvt_pk_bf16(o[2], o[3]); w.z = cvt_pk_bf16(o[4], o[5]); w.w = cvt_pk_bf16(o[6], o[7]);
            *(u32x4*)(cbuf + (t + q) * DRNN + f) = w;
        }
    }
}
__device__ void scan_phase(const int bid, const int nblk, bf16_t* __restrict__ U, const unsigned* __restrict__ LB, long Tc, int CB, float* sm) {
    const int wid = tid_() >> 6, lane = tid_() & 63;
    const int nitems = CB * (DRNN / 128);
    for (int it = bid; it < nitems; it += nblk) {
        const int bi = it / (DRNN / 128), cgp = it - bi * (DRNN / 128); const int ch = cgp * 128 + lane * 2;
        const long row0 = (long)bi * SEQ + wid * 256;
        const unsigned* lf = LB + row0 * DRNN + ch; const unsigned* lb = lf + Tc * DRNN;
        float Sf0 = 0.f, Sf1 = 0.f, Bf0 = 0.f, Bf1 = 0.f, Sb0 = 0.f, Sb1 = 0.f, Bb0 = 0.f, Bb1 = 0.f;
#pragma unroll 16
        for (int t = 0; t < 256; ++t) {
            const u32x2 w1 = *(const u32x2*)(lf + (long)t * DRNN);
            Bf0 = __expf(bflo(w1.x)) * Bf0 + bfhi(w1.x); Sf0 += bflo(w1.x); Bf1 = __expf(bflo(w1.y)) * Bf1 + bfhi(w1.y); Sf1 += bflo(w1.y);
            const int tb = 255 - t;
            const u32x2 w2 = *(const u32x2*)(lb + (long)tb * DRNN);
            Bb0 = __expf(bflo(w2.x)) * Bb0 + bfhi(w2.x); Sb0 += bflo(w2.x); Bb1 = __expf(bflo(w2.y)) * Bb1 + bfhi(w2.y); Sb1 += bflo(w2.y);
        }
        float* my = sm + (wid * 64 + lane) * 8;
        my[0] = __expf(Sf0); my[1] = Bf0; my[2] = __expf(Sb0); my[3] = Bb0; my[4] = __expf(Sf1); my[5] = Bf1; my[6] = __expf(Sb1); my[7] = Bb1;
        __syncthreads();
        float hf0 = 0.f, hb0 = 0.f, hf1 = 0.f, hb1 = 0.f;
        for (int s = 0; s < wid; ++s) { const float* o = sm + (s * 64 + lane) * 8; hf0 = o[0] * hf0 + o[1]; hf1 = o[4] * hf1 + o[5]; }
        for (int s = 7; s > wid; --s) { const float* o = sm + (s * 64 + lane) * 8; hb0 = o[2] * hb0 + o[3]; hb1 = o[6] * hb1 + o[7]; }
        __syncthreads();
        bf16_t* Ug = U + row0 * (2 * DRNN) + ch;
#pragma unroll 16
        for (int t = 0; t < 256; ++t) {
            const u32x2 w1 = *(const u32x2*)(lf + (long)t * DRNN);
            hf0 = __expf(bflo(w1.x)) * hf0 + bfhi(w1.x); hf1 = __expf(bflo(w1.y)) * hf1 + bfhi(w1.y);
            *(unsigned*)(Ug + (long)t * (2 * DRNN) + DRNN) = cvt_pk_bf16(hf0, hf1);
        }
#pragma unroll 16
        for (int t = 255; t >= 0; --t) {
            const u32x2 w2 = *(const u32x2*)(lb + (long)t * DRNN);
            hb0 = __expf(bflo(w2.x)) * hb0 + bfhi(w2.x); hb1 = __expf(bflo(w2.y)) * hb1 + bfhi(w2.y);
            const unsigned hfw = *(const unsigned*)(Ug + (long)t * (2 * DRNN) + DRNN), gw = *(const unsigned*)(Ug + (long)t * (2 * DRNN));
            *(unsigned*)(Ug + (long)t * (2 * DRNN)) = cvt_pk_bf16((bflo(hfw) + hb0) * bflo(gw), (bfhi(hfw) + hb1) * bfhi(gw));
        }
    }
}

__device__ void lru_fused_phase(const int bid, const int nblk, bf16_t* __restrict__ U, bf16_t* __restrict__ HF, const bf16_t* __restrict__ Wg, const float* __restrict__ cw, const float* __restrict__ cb,
                                const float* __restrict__ b_a, const float* __restrict__ b_i, const float* __restrict__ c8sp, int CB, unsigned char* smem) {
    constexpr int RS = 272;
    const int tid = tid_(), wid = tid >> 6, lane = tid & 63, fr = lane & 15, fq = lane >> 4;
    const int nitems = CB * 10;
    for (int it = bid; it < nitems; it += nblk) {
        const int bi = it / 10, h = it - bi * 10;
        const long rowb = (long)bi * SEQ;
        const int chl = 16 * wid + fr, ch = h * 128 + chl;
        const int sch = h * 128 + 2 * lane;
        float w0[2], w1[2], w2[2], w3[2], wb[2];
#pragma unroll
        for (int q = 0; q < 2; ++q) { w0[q] = cw[sch + q]; w1[q] = cw[DRNN + sch + q]; w2[q] = cw[2 * DRNN + sch + q]; w3[q] = cw[3 * DRNN + sch + q]; wb[q] = cb[sch + q]; }
        const bf16_t* recp = U + rowb * (2 * DRNN) + DRNN + sch;
        for (int e = 0; e < 2; ++e) {
            bf16x8 Bf[2][4];
#pragma unroll
            for (int g = 0; g < 2; ++g)
#pragma unroll
                for (int s = 0; s < 4; ++s) Bf[g][s] = *(const bf16x8*)(Wg + ((long)((e * 10 + h) * 256 + g * 128 + chl)) * 128 + 32 * s + 8 * fq);
            const float ba = b_a[e * DRNN + ch], bi_ = b_i[e * DRNN + ch], sp = c8sp[e * DRNN + ch];
            float hs = 0.f;
            unsigned xr[11];
            {
                const int k = e == 0 ? 0 : 31; const int p0 = 64 * k + 8 * wid - 2;
#pragma unroll
                for (int i = 0; i < 11; ++i) { const int pos = p0 + i; xr[i] = (pos >= 0 && pos < SEQ) ? *(const unsigned*)(recp + (long)pos * (2 * DRNN)) : 0u; }
#pragma unroll
                for (int r = 0; r < 8; ++r) {
                    const float c0 = wb[0] + w0[0] * bflo(xr[r]) + w1[0] * bflo(xr[r + 1]) + w2[0] * bflo(xr[r + 2]) + w3[0] * bflo(xr[r + 3]);
                    const float c1 = wb[1] + w0[1] * bfhi(xr[r]) + w1[1] * bfhi(xr[r + 1]) + w2[1] * bfhi(xr[r + 2]) + w3[1] * bfhi(xr[r + 3]);
                    *(unsigned*)(smem + (8 * wid + r) * RS + lane * 4) = cvt_pk_bf16(c0, c1);
                }
            }
            __syncthreads();
            for (int kk = 0; kk < 32; ++kk) {
                const int k = e == 0 ? kk : 31 - kk;
                unsigned char* buf = smem + (kk & 1) * (64 * RS);
                if (kk + 1 < 32) {
                    const int kn = e == 0 ? kk + 1 : 30 - kk; const int p0 = 64 * kn + 8 * wid - 2;
#pragma unroll
                    for (int i = 0; i < 11; ++i) { const int pos = p0 + i; xr[i] = (pos >= 0 && pos < SEQ) ? *(const unsigned*)(recp + (long)pos * (2 * DRNN)) : 0u; }
                }
#pragma unroll
                for (int rti = 0; rti < 4; ++rti) {
                    const int rt = e == 0 ? rti : 3 - rti;
                    const long grow = rowb + 64 * k + 16 * rt + 4 * fq;
                    unsigned short hfv[4], gtv[4];
                    if (e == 1) {
#pragma unroll
                        for (int j = 0; j < 4; ++j) { hfv[j] = HF[(grow + j) * DRNN + ch]; gtv[j] = U[(grow + j) * (2 * DRNN) + ch]; }
                    }
                    f32x4 za = {0.f, 0.f, 0.f, 0.f}, zi = {0.f, 0.f, 0.f, 0.f};
#pragma unroll
                    for (int s = 0; s < 4; ++s) {
                        const bf16x8 af = *(const bf16x8*)(buf + (16 * rt + fr) * RS + (32 * s + 8 * fq) * 2);
                        za = __builtin_amdgcn_mfma_f32_16x16x32_bf16(af, Bf[0][s], za, 0, 0, 0);
                        zi = __builtin_amdgcn_mfma_f32_16x16x32_bf16(af, Bf[1][s], zi, 0, 0, 0);
                    }
                    float av[4], bv[4];
#pragma unroll
                    for (int j = 0; j < 4; ++j) {
                        const float c = bf2f(*(const unsigned short*)(buf + (16 * rt + 4 * fq + j) * RS + chl * 2));
                        const float r = sigmoidf(za[j] + ba), ig = sigmoidf(zi[j] + bi_);
                        const float la = -sp * r;
                        av[j] = __expf(la);
                        bv[j] = __builtin_sqrtf(fmaxf(1.0f - av[j] * av[j], 0.f)) * ig * c;
                    }
                    float hl[4], pp[4];
                    if (e == 0) { hl[0] = bv[0]; pp[0] = av[0];
#pragma unroll
                        for (int j = 1; j < 4; ++j) { hl[j] = av[j] * hl[j - 1] + bv[j]; pp[j] = av[j] * pp[j - 1]; } }
                    else { hl[3] = bv[3]; pp[3] = av[3];
#pragma unroll
                        for (int j = 2; j >= 0; --j) { hl[j] = av[j] * hl[j + 1] + bv[j]; pp[j] = av[j] * pp[j + 1]; } }
                    const float Ag = e == 0 ? pp[3] : pp[0], Hg = e == 0 ? hl[3] : hl[0];
                    float A4[4], H4[4];
#pragma unroll
                    for (int f = 0; f < 4; ++f) { A4[f] = __shfl(Ag, fr + 16 * f, 64); H4[f] = __shfl(Hg, fr + 16 * f, 64); }
                    float carry, sN;
                    if (e == 0) { const float s0 = hs, s1 = A4[0] * s0 + H4[0], s2 = A4[1] * s1 + H4[1], s3 = A4[2] * s2 + H4[2]; sN = A4[3] * s3 + H4[3];
                        carry = fq == 0 ? s0 : (fq == 1 ? s1 : (fq == 2 ? s2 : s3)); }
                    else { const float t0 = hs, t1 = A4[3] * t0 + H4[3], t2 = A4[2] * t1 + H4[2], t3 = A4[1] * t2 + H4[1]; sN = A4[0] * t3 + H4[0];
                        carry = fq == 3 ? t0 : (fq == 2 ? t1 : (fq == 1 ? t2 : t3)); }
                    hs = sN;
#pragma unroll
                    for (int j = 0; j < 4; ++j) {
                        const float hv = hl[j] + pp[j] * carry;
                        if (e == 0) HF[(grow + j) * DRNN + ch] = f2bf(hv);
                        else U[(grow + j) * (2 * DRNN) + ch] = f2bf((bf2f(hfv[j]) + hv) * bf2f(gtv[j]));
                    }
                }
                if (kk + 1 < 32) {
                    unsigned char* nb = smem + ((kk + 1) & 1) * (64 * RS);
#pragma unroll
                    for (int r = 0; r < 8; ++r) {
                        const float c0 = wb[0] + w0[0] * bflo(xr[r]) + w1[0] * bflo(xr[r + 1]) + w2[0] * bflo(xr[r + 2]) + w3[0] * bflo(xr[r + 3]);
                        const float c1 = wb[1] + w0[1] * bfhi(xr[r]) + w1[1] * bfhi(xr[r + 1]) + w2[1] * bfhi(xr[r + 2]) + w3[1] * bfhi(xr[r + 3]);
                        *(unsigned*)(nb + (8 * wid + r) * RS + lane * 4) = cvt_pk_bf16(c0, c1);
                    }
                }
                __syncthreads();
            }
        }
    }
}

#define XB_TMO      128
#define XB_XCNT(j)  (256  + 64 * (j))
#define XB_XSUB(j)  (1280 + 64 * (j))
#define XB_XGEN(j)  (2304 + 64 * (j))
#define XB_TOP      3328
#define XB_TOPGEN   3392
#define XCD_BAR_WORDS 3456
#define XB_SPIN_CAP (1u << 22)
__device__ __forceinline__ unsigned xb_ld(unsigned* p)              { return __hip_atomic_load(p, __ATOMIC_RELAXED, __HIP_MEMORY_SCOPE_AGENT); }
__device__ __forceinline__ unsigned xb_add(unsigned* p, unsigned v) { return __hip_atomic_fetch_add(p, v, __ATOMIC_RELAXED, __HIP_MEMORY_SCOPE_AGENT); }
__device__ __forceinline__ unsigned xb_xcc_id() { return (unsigned)__builtin_amdgcn_s_getreg((3 << 11) | 20) & 0xFu; }
#define XB_SPIN(cond, bar) do { unsigned _sp = 0; while (cond) { __builtin_amdgcn_s_sleep(1); \
    if ((++_sp & 255u) == 0u) { if (xb_ld(&(bar)[XB_TMO])) break; if (_sp > XB_SPIN_CAP) { atomicAdd(&(bar)[XB_TMO], 1u); break; } } } } while (0)
__device__ __forceinline__ void xcd_barrier_complete(unsigned* bar, unsigned x, unsigned G, unsigned& nloc, unsigned& nx) {
    unsigned sum, cnt, mine, sp = 0u;
    for (;;) {
        sum = 0u; cnt = 0u; mine = 0u;
#pragma unroll
        for (unsigned j = 0; j < 16; ++j) { const unsigned c = xb_ld(&bar[XB_XCNT(j)]); sum += c; cnt += (c > 0u) ? 1u : 0u; mine = (j == x) ? c : mine; }
        if (sum == G) break;
        __builtin_amdgcn_s_sleep(1);
        if ((++sp & 255u) == 0u) { if (xb_ld(&bar[XB_TMO])) break; if (sp > XB_SPIN_CAP) { atomicAdd(&bar[XB_TMO], 1u); break; } }
    }
    nloc = mine > 0u ? mine : 1u; nx = cnt > 0u ? cnt : 1u;
}
__device__ __forceinline__ void xcd_barrier(unsigned* bar, volatile LAS unsigned* st, unsigned G) {
    asm volatile("s_waitcnt vmcnt(0)" ::: "memory");
    __syncthreads();
    if (tid_() == 0) {
        const unsigned x = xb_xcc_id();
        __builtin_amdgcn_s_waitcnt(0);
        unsigned nloc = st[0], nx = st[1];
        if (nloc == 0u) { xcd_barrier_complete(bar, x, G, nloc, nx); st[0] = nloc; st[1] = nx; }
        const unsigned old = xb_add(&bar[XB_XSUB(x)], 1u);
        const unsigned gen = old / nloc;
        if (old + 1u == (gen + 1u) * nloc) {
            __builtin_amdgcn_fence(__ATOMIC_RELEASE, "agent");
            asm volatile("s_waitcnt vmcnt(0)" ::: "memory");
            const unsigned og = xb_add(&bar[XB_TOP], 1u);
            const unsigned tg = og / nx;
            if (og + 1u == (tg + 1u) * nx) xb_add(&bar[XB_TOPGEN], 1u);
            else XB_SPIN(xb_ld(&bar[XB_TOPGEN]) == tg, bar);
            __builtin_amdgcn_fence(__ATOMIC_ACQUIRE, "agent");
            xb_add(&bar[XB_XGEN(x)], 1u);
            asm volatile("s_waitcnt vmcnt(0)" ::: "memory");
        } else {
            XB_SPIN(xb_ld(&bar[XB_XGEN(x)]) == gen, bar);
            __builtin_amdgcn_fence(__ATOMIC_ACQUIRE, "agent");
            asm volatile("s_waitcnt vmcnt(0)" ::: "memory");
        }
    }
    __syncthreads();
}

__device__ __forceinline__ void block_seam() {
    asm volatile("s_waitcnt vmcnt(0)" ::: "memory");
    __syncthreads();
    if (tid_() == 0) { __builtin_amdgcn_fence(__ATOMIC_ACQUIRE, "agent"); asm volatile("s_waitcnt vmcnt(0)" ::: "memory"); }
    __syncthreads();
}

__device__ void prologue_phase(const int bid, const int nblk, const int z0, const Params& p, float* smf) {
    transpose_job(bid, nblk, smf, p.in[5 + z0], p.wp[WP_FNET + z0], DM, DM, 1, 0, 1.0f);
    transpose_job(bid, nblk, smf, p.in[7 + z0], p.wp[WP_IN + z0], DM, 2 * DRNN, 1, 0, 1.0f);
    transpose_job(bid, nblk, smf, p.in[15 + z0], p.wp[WP_LOUT + z0], DRNN, DM, 1, 0, 1.0f);
    transpose_job(bid, nblk, smf, p.in[18 + z0], p.wp[WP_Q + z0], DM, DM, 2, (long)DM * DM, 0.0625f);
    transpose_job(bid, nblk, smf, p.in[19 + z0], p.wp[WP_KV + z0], DM, 2 * DM, 2, (long)2 * DM * DM, 1.0f);
    transpose_job(bid, nblk, smf, p.in[20 + z0], p.wp[WP_O + z0], DM, DM, 2, (long)DM * DM, 1.0f);
    transpose_job(bid, nblk, smf, p.in[22 + z0], p.wp[WP_UP + z0], DM, 2 * DFF, 2, (long)2 * DFF * DM, 1.0f);
    transpose_job(bid, nblk, smf, p.in[25 + z0], p.wp[WP_DOWN + z0], DFF, DM, 2, (long)DFF * DM, 1.0f);
    transpose_job(bid, nblk, smf, p.in[10 + z0], p.wp[WP_GATE + z0], 128, 128, 20, 256 * 128, 1.0f);
    transpose_job(bid, nblk, smf, p.in[12 + z0], p.wp[WP_GATE + z0] + 128 * 128, 128, 128, 20, 256 * 128, 1.0f);
    const long gtid = (long)bid * 512 + tid_(), gth = (long)nblk * 512;
    for (long i = gtid; i < 512 * 256; i += gth) { const int m = (int)(i >> 8), c = (int)(i & 255), cp = m >> 1; const int idx = (c * cp) & 255;
        const float ang = (float)idx * (1.0f / 128.0f); p.wp[WP_CS + z0][i] = f2bf(((m & 1) ? sinpif(ang) : cospif(ang)) * 0.0625f); }
    for (long i = gtid; i < (long)SEQ * 2 * SEQ; i += gth) { const int sp = (int)(i >> 12), k = (int)(i & 4095), s = k & 2047; const int idx = (sp * s) & 2047;
        const float ang = (float)idx * (1.0f / 1024.0f); p.wp[WP_DFTA + z0][i] = f2bf((k < SEQ ? cospif(ang) : -sinpif(ang)) * 0.022097086912f); }
    for (long i = gtid; i < 2 * DRNN; i += gth) p.c8sp[i] = 8.0f * log1pf(__expf(-p.in[14 + z0][i]));
    for (int l = 0; l < 2; ++l)
        rms_phase(bid, nblk, 0, (long)NB * NMEM, p.in[2 + z0], p.in[3 + z0], (long)16 * NMEM, p.in[17 + z0] + l * DM, p.wp[WP_MN + z0] + (long)l * NB * NMEM * DM, nullptr);
}

constexpr int NSTEP = 27;
__global__ __launch_bounds__(512, 2) void mega(Params p) {
    extern __shared__ __attribute__((aligned(16))) unsigned char shm[];
    cg::grid_group grid = cg::this_grid();
    volatile LAS unsigned* st = (volatile LAS unsigned*)((LAS unsigned char*)shm + (LDS_BYTES - 16));
    if (threadIdx.x == 0) { st[0] = 0u; st[1] = 0u; (void)xb_add(&p.bar[XB_XCNT(xb_xcc_id())], 1u); }
    grid.sync();
    const int total = 3 + p.nch * NSTEP;
    for (int pc = 0; pc < total; ++pc) {
        int z0; asm volatile("s_mov_b32 %0, 0" : "=s"(z0));
        const int bid = blockIdx.x + z0, nblk = gridDim.x + z0;
        int kind, arg, chunk;
        if (pc < 3) { kind = pc == 0 ? K_PROLOGUE : K_GEMM; arg = 17 + pc; chunk = 0; }
        else { const int q = pc - 3; chunk = q / NSTEP; const int s = q - chunk * NSTEP; kind = p.kind[s]; arg = p.arg[s]; }
        const int local_seam = arg >> 7; arg &= 0x7f;
        if (kind == K_GEMM) {
            if (arg == 1 && pc >= 3) dft_row1024_job(bid, nblk, (const bf16_t*)(p.R1 + z0), p.wp[WP_R0 + z0], p.CB + z0);
            gemm_phase(bid, nblk, (LAS unsigned char*)shm, arg, chunk, p);
        } else {
            const int CB = p.CB + z0; const long Tc = (long)CB * SEQ; const long r0 = (long)chunk * Tc;
            float* smf = (float*)shm;
            unsigned char* R1 = p.R1 + z0; bf16_t* R0 = p.wp[WP_R0 + z0]; float* out = p.out + z0;
#define IN(k) p.in[(k) + z0]
            switch (kind) {
                case K_PROLOGUE: prologue_phase(bid, nblk, z0, p, smf); break;
                case K_RMS_IN: rms_phase(bid, nblk, r0, Tc, IN(0), IN(1), (long)16 * SEQ, IN(4), R0, p.xr + z0); break;
                case K_RMS_MIX1: rms_bf_phase(bid, nblk, Tc, p.xr + z0, IN(4) + DM, R0); break;
                case K_RMS_XA: rms_bf_phase(bid, nblk, Tc, p.xr + z0, IN(16) + arg * DM, R0); break;
                case K_RMS_FFN: rms_bf_phase(bid, nblk, Tc, p.xr + z0, IN(21) + arg * DM, R0); break;
                case K_SOFTMAX: softmax_phase(bid, nblk, (const float*)(R1 + Tc * 2048), (bf16_t*)R1, Tc * 4); break;
                case K_FFNFIX: ffn_fix_phase(bid, nblk, (bf16_t*)R1, (int)(Tc / BM), p.edge + z0, IN(23) + arg * 3 * DFF); break;
                case K_FFNCONV: ffn_conv_phase(bid, nblk, (bf16_t*)R1, Tc, IN(23) + arg * 3 * DFF, IN(24) + arg * DFF); break;
                case K_LRUCONV: lru_conv_phase(bid, nblk, (const bf16_t*)R1, (bf16_t*)(R1 + Tc * 5120), Tc, IN(8), IN(9)); break;
                case K_LRU: lru_fused_phase(bid, nblk, (bf16_t*)R1, (bf16_t*)(R1 + Tc * 5120), p.wp[WP_GATE + z0], IN(8), IN(9), IN(11), IN(13), p.c8sp + z0, CB, (unsigned char*)shm); break;
                case K_SCAN: scan_phase(bid, nblk, (bf16_t*)R1, (const unsigned*)(R1 + Tc * 7680), Tc, CB, smf); break;
                case K_FINAL: final_norm_phase(bid, nblk, p.xr + z0, out + r0 * DM, Tc, IN(26)); break;
                default: break;
            }
#undef IN
        }
        if (local_seam) block_seam();
        else if (pc != 1 && pc != total - 1) xcd_barrier(p.bar + z0, st, (unsigned)nblk);
    }
}

static GemmDesc mkdesc(const void* A, const void* B, void* C, const float* bias, int nM, int nN, int nZ, int zdiv,
                       long aZ1, long aZ2, long bZ1, long bZ2, long aTile, long bTile, long cZ1, long cZ2, int csz,
                       long aCh, long bCh, long cCh, int K, int lda, int ldb, int ldc, int epi, int gelu_pn) {
    GemmDesc d{};
    d.A = (const char*)A; d.B = (const char*)B; d.C = (char*)C; d.bias = bias;
    d.aZ1 = (unsigned)(aZ1 * 2); d.aZ2 = (unsigned)(aZ2 * 2); d.bZ1 = (unsigned)(bZ1 * 2); d.bZ2 = (unsigned)(bZ2 * 2); d.aTile = (unsigned)(aTile * 2); d.bTile = (unsigned)(bTile * 2);
    d.cZ1 = (unsigned)(cZ1 * csz); d.cZ2 = (unsigned)(cZ2 * csz);
    d.aCh = (unsigned)(aCh * 2); d.bCh = (unsigned)(bCh * 2); d.cCh = (unsigned)(cCh * csz);
    d.bhalf = 128;
    { auto magic = [](unsigned dd) { return (unsigned)((0x100000000ull / dd) + 1ull); };
      d.mper = magic((unsigned)(nM * nN)); d.mnig = magic((unsigned)(8 * nN)); d.mgsz = magic((unsigned)(nM < 8 ? nM : 8)); d.mzdiv = zdiv > 1 ? magic((unsigned)zdiv) : 0u; d.padm = 0u; }
    d.nM = nM; d.nN = nN; d.nZ = nZ; d.zdiv = zdiv; d.K = K; d.lda = lda; d.ldb = ldb; d.ldc = ldc; d.epi = epi; d.gelu_pn = gelu_pn;
    return d;
}

extern "C" void kernel_launch(void* const* d_in, const int* in_sizes, int n_in, void* d_out, int out_size, void* d_ws, size_t ws_size, hipStream_t stream) {
    static int grid = 0;
    if (grid == 0) {
        int dev = 0, cus = 0, per_cu = 0;
        (void)hipGetDevice(&dev);
        (void)hipDeviceGetAttribute(&cus, hipDeviceAttributeMultiprocessorCount, dev);
        if (hipFuncSetAttribute((const void*)mega, hipFuncAttributeMaxDynamicSharedMemorySize, LDS_BYTES) != hipSuccess) { fprintf(stderr, "hipFuncSetAttribute failed\n"); }
        if (hipOccupancyMaxActiveBlocksPerMultiprocessor(&per_cu, (const void*)mega, 512, LDS_BYTES) != hipSuccess || per_cu < 1) per_cu = 1;
        (void)hipGetLastError();
        grid = cus * per_cu;
    }
    Params p{};
    for (int i = 0; i < 27; ++i) p.in[i] = (const float*)d_in[i];
    p.out = (float*)d_out;
    size_t off = 0; unsigned char* ws = (unsigned char*)d_ws;
    auto take = [&](size_t bytes) { unsigned char* r = ws + off; off += (bytes + 255) & ~(size_t)255; return r; };
    p.wp[WP_FNET] = (bf16_t*)take((size_t)DM * DM * 2);
    p.wp[WP_IN] = (bf16_t*)take((size_t)2 * DRNN * DM * 2);
    p.wp[WP_GATE] = (bf16_t*)take((size_t)20 * 256 * 128 * 2);
    p.wp[WP_LOUT] = (bf16_t*)take((size_t)DM * DRNN * 2);
    p.wp[WP_Q] = (bf16_t*)take((size_t)2 * DM * DM * 2);
    p.wp[WP_KV] = (bf16_t*)take((size_t)2 * 2 * DM * DM * 2);
    p.wp[WP_O] = (bf16_t*)take((size_t)2 * DM * DM * 2);
    p.wp[WP_UP] = (bf16_t*)take((size_t)2 * 2 * DFF * DM * 2);
    p.wp[WP_DOWN] = (bf16_t*)take((size_t)2 * DM * DFF * 2);
    p.wp[WP_CS] = (bf16_t*)take((size_t)512 * 256 * 2);
    p.wp[WP_DFTA] = (bf16_t*)take((size_t)SEQ * 2 * SEQ * 2);
    p.c8sp = (float*)take((size_t)2 * DRNN * 4);
    p.bar = (unsigned*)take((size_t)XCD_BAR_WORDS * 4);
    p.wp[WP_MN] = (bf16_t*)take((size_t)2 * NB * NMEM * DM * 2);
    bf16_t* Kmat = (bf16_t*)take((size_t)2 * NB * NMEM * DM * 2);
    bf16_t* VT = (bf16_t*)take((size_t)2 * NB * NMEM * DM * 2);
    const int cands[7] = {48, 24, 16, 8, 4, 2, 1};
    int CB = 1;
    for (int i = 0; i < 7; ++i) { const size_t need = off + (size_t)cands[i] * SEQ * (2048 + 7680 + 544 + 2048) + 8192; if (need <= ws_size) { CB = cands[i]; break; } }
    p.CB = CB; p.nch = NB / CB;
    const long Tc = (long)CB * SEQ; const int nMt = (int)(Tc / BM);
    p.wp[WP_R0] = (bf16_t*)take((size_t)Tc * 2048);
    p.R1 = take((size_t)Tc * 7680);
    p.edge = (float*)take((size_t)3 * nMt * 2 * DFF * 4);
    p.xr = (bf16_t*)take((size_t)Tc * 2048);
    bf16_t* XR = p.xr;
    bf16_t* R0 = p.wp[WP_R0]; unsigned char* R1 = p.R1;
    bf16_t* Ob = (bf16_t*)(R1 + Tc * 4096);
    bf16_t* YT = (bf16_t*)R1; bf16_t* Q = (bf16_t*)R1; bf16_t* Pb = (bf16_t*)(R1 + Tc * 2048); bf16_t* GV = (bf16_t*)R1;
    bf16_t* U = (bf16_t*)R1; bf16_t* cbuf = (bf16_t*)(R1 + Tc * 5120); bf16_t* LA = (bf16_t*)(R1 + Tc * 7680);
    float* out = p.out;
    const long MD = (long)NMEM * DM, SD = (long)SEQ * DM;
    p.g[0] = mkdesc(p.wp[WP_CS], R0, YT, nullptr, 2, 8, CB * 4, 4, 0, 0, SD, 256, 256 * 256, 256 * DM, (long)4 * 512 * SEQ, (long)512 * SEQ, 2, 0, 0, 0, 256, 256, DM, SEQ, E_BF16, 0);
    p.g[1] = mkdesc(p.wp[WP_DFTA], YT, R0, nullptr, 4, 4, CB, 1, 0, 0, (long)DM * 2 * SEQ, 0, (long)256 * 2 * SEQ, (long)256 * 2 * SEQ, SD, 0, 2, 0, 0, 0, 2 * SEQ, 2 * SEQ, 2 * SEQ, DM, E_DFT, 0);
    p.g[2] = mkdesc(R0, p.wp[WP_FNET], XR, p.in[6], nMt, 4, 1, 1, 0, 0, 0, 0, 256 * DM, 256 * DM, 0, 0, 2, 0, 0, 0, DM, DM, DM, DM, E_RESID, 0);
    for (int l = 0; l < 2; ++l) {
        const int b = 3 + l * 6;
        p.g[b + 0] = mkdesc(R0, p.wp[WP_Q] + (long)l * DM * DM, Q, nullptr, nMt, 4, 1, 1, 0, 0, 0, 0, 256 * DM, 256 * DM, 0, 0, 2, 0, 0, 0, DM, DM, DM, DM, E_BF16, 0);
        p.g[b + 1] = mkdesc(Q, Kmat + (long)l * NB * MD, Pb, nullptr, 8, 1, CB * 4, 4, SD, 256, MD, 256, 256 * DM, 0, SD, 256, 2, 0, (long)CB * MD, 0, 256, DM, DM, DM, E_SOFTMAX, 0);
        p.g[b + 2] = mkdesc(Pb, VT + (long)l * NB * MD, Ob, nullptr, 8, 1, CB * 4, 4, SD, 256, MD, (long)256 * NMEM, 256 * DM, 0, SD, 256, 2, 0, (long)CB * MD, 0, 256, DM, NMEM, DM, E_BF16, 0);
        p.g[b + 3] = mkdesc(Ob, p.wp[WP_O] + (long)l * DM * DM, XR, nullptr, nMt, 4, 1, 1, 0, 0, 0, 0, 256 * DM, 256 * DM, 0, 0, 2, 0, 0, 0, DM, DM, DM, DM, E_RESID, 0);
        p.g[b + 4] = mkdesc(R0, p.wp[WP_UP] + (long)l * 2 * DFF * DM, GV, nullptr, nMt, 22, 1, 1, 0, 0, 0, 0, 256 * DM, 128 * DM, 0, 0, 2, 0, 0, 0, DM, DM, DM, DFF, E_FFN, l);
        p.g[b + 4].bhalf = DFF;
        p.g[b + 5] = mkdesc(GV, p.wp[WP_DOWN] + (long)l * DM * DFF, XR, nullptr, nMt, 4, 1, 1, 0, 0, 0, 0, (long)256 * DFF, (long)256 * DFF, 0, 0, 2, 0, 0, 0, DFF, DFF, DFF, DM, E_RESID, 0);
    }
    p.g[15] = mkdesc(R0, p.wp[WP_IN], U, nullptr, nMt, 10, 1, 1, 0, 0, 0, 0, 256 * DM, 256 * DM, 0, 0, 2, 0, 0, 0, DM, DM, DM, 2 * DRNN, E_BF16, 5);
    p.g[16] = mkdesc(cbuf, p.wp[WP_GATE], LA, nullptr, nMt, 1, 20, 10, 0, 128, (long)10 * 256 * 128, (long)256 * 128, (long)256 * DRNN, 0, 0, 0, 2, 0, 0, 0, 128, DRNN, 128, DRNN, E_GATE, 0);
    p.g[17] = mkdesc(U, p.wp[WP_LOUT], XR, nullptr, nMt, 4, 1, 1, 0, 0, 0, 0, (long)256 * 2 * DRNN, (long)256 * DRNN, 0, 0, 2, 0, 0, 0, DRNN, 2 * DRNN, DRNN, DM, E_RESID, 0);
    p.g[18] = mkdesc(p.wp[WP_MN], p.wp[WP_KV], Kmat, nullptr, NB, 4, 2, 1, (long)NB * MD, 0, (long)2 * DM * DM, 0, 256 * DM, 256 * DM, (long)NB * MD, 0, 2, 0, 0, 0, DM, DM, DM, DM, E_BF16, 0);
    p.g[19] = mkdesc(p.wp[WP_KV] + (long)DM * DM, p.wp[WP_MN], VT, nullptr, 4, 1, 2 * NB, NB, (long)2 * DM * DM, 0, (long)NB * MD, MD, 256 * DM, 0, (long)NB * MD, MD, 2, 0, 0, 0, DM, DM, DM, NMEM, E_BF16, 0);
    p.g[1].padm = 1u;
    for (int l = 0; l < 2; ++l) { const int b = 3 + l * 6; p.g[b + 0].padm = 1u; p.g[b + 1].padm = 1u; p.g[b + 2].padm = 1u;
                                  p.g[b + 4].padm = 1u; }
    p.g[15].padm = 1u;
    const unsigned char kinds[NSTEP] = {K_RMS_IN, K_GEMM, K_GEMM, K_GEMM, K_RMS_XA, K_GEMM, K_GEMM, K_GEMM, K_GEMM, K_RMS_FFN, K_GEMM, K_FFNFIX, K_GEMM,
                                         K_RMS_MIX1, K_GEMM, K_LRU, K_GEMM, K_RMS_XA, K_GEMM, K_GEMM, K_GEMM, K_GEMM, K_RMS_FFN, K_GEMM, K_FFNFIX, K_GEMM, K_FINAL};
    const unsigned char LS = 0x80;
    const unsigned char args_[NSTEP] = {0, 0, 1, 2, 0, (unsigned char)(3 | LS), (unsigned char)(4 | LS), 5, 6, 0, 7, 0, 8,
                                         0, 15, 0, 17, 1, (unsigned char)(9 | LS), (unsigned char)(10 | LS), 11, 12, 1, 13, 1, 14, 0};
    for (int i = 0; i < NSTEP; ++i) { p.kind[i] = kinds[i]; p.arg[i] = args_[i]; }
    (void)hipMemsetAsync(p.bar, 0, (size_t)XCD_BAR_WORDS * 4, stream);
    void* args[] = {&p};
    hipError_t e = hipLaunchCooperativeKernel((const void*)mega, dim3(grid), dim3(512), args, LDS_BYTES, stream);
    if (e != hipSuccess) fprintf(stderr, "cooperative launch failed: %s (grid %d)\n", hipGetErrorString(e), grid);
}
```

```cpp
#include <hip/hip_runtime.h>
#include <hip/hip_cooperative_groups.h>
#include <cstdio>
namespace cg = cooperative_groups;

#define LAS __attribute__((address_space(3)))
typedef unsigned short bf16_t;
typedef short bf16x8 __attribute__((ext_vector_type(8)));
typedef float f32x4 __attribute__((ext_vector_type(4)));
typedef unsigned u32x4 __attribute__((ext_vector_type(4)));
typedef unsigned u32x2 __attribute__((ext_vector_type(2)));

constexpr int BM = 256, BK = 64, HALF = 128, HTB = HALF * BK * 2, STAGE_BYTES = 8 * HTB;
constexpr int LDS_BYTES = STAGE_BYTES + 8192;
constexpr int NB = 48, SEQ = 2048, DM = 1024, NMEM = 256, DRNN = 1280, DFF = 2816;

__device__ __forceinline__ int lds_byte(int r, int c) { const int st = (r >> 4) * 2 + (c >> 5), rr = r & 15, cc = c & 31, ob = rr * 64 + cc * 2; return st * 1024 + (ob ^ (((ob >> 9) & 1) << 5)); }
__device__ __forceinline__ void stage_rc(int b, int& R, int& C) { const int st = b / 1024, sb = b % 1024, swz = sb ^ (((sb >> 9) & 1) << 5); R = (st >> 1) * 16 + swz / 64; C = (st & 1) * 32 + (swz % 64) / 2; }
__device__ __forceinline__ int perm32(int rho) { const int n = rho >> 4, i = rho & 15; return 8 * (i >> 2) + 4 * n + (i & 3); }
__device__ __forceinline__ unsigned cvt_pk_bf16(float lo, float hi) { unsigned r; asm volatile("v_cvt_pk_bf16_f32 %0, %1, %2" : "=v"(r) : "v"(lo), "v"(hi)); return r; }
__device__ __forceinline__ bf16_t f2bf(float f) { unsigned u = __float_as_uint(f); u += 0x7FFFu + ((u >> 16) & 1u); return (bf16_t)(u >> 16); }
__device__ __forceinline__ float bf2f(bf16_t b) { return __uint_as_float(((unsigned)b) << 16); }
__device__ __forceinline__ float bflo(unsigned w) { return __uint_as_float(w << 16); }
__device__ __forceinline__ float bfhi(unsigned w) { return __uint_as_float(w & 0xffff0000u); }
__device__ __forceinline__ float gelu_tanh(float x) { const float u = 1.5957691216f * (x + 0.044715f * x * x * x); return x * __builtin_amdgcn_rcpf(1.0f + __expf(-u)); }
typedef float f32x2 __attribute__((ext_vector_type(2)));
__device__ __forceinline__ f32x2 gelu_tanh2(f32x2 x) {
    const f32x2 t = x * x;
    const f32x2 w = x * (t * (-0.10294324f) + (-2.3022082f));
    f32x2 e; e.x = __builtin_amdgcn_exp2f(w.x); e.y = __builtin_amdgcn_exp2f(w.y);
    const f32x2 d = e + 1.0f;
    f32x2 r; r.x = __builtin_amdgcn_rcpf(d.x); r.y = __builtin_amdgcn_rcpf(d.y);
    return x * r;
}
__device__ __forceinline__ int tid_() { int t = threadIdx.x; asm volatile("" : "+v"(t)); return t; }
__device__ __forceinline__ float sigmoidf(float z) { return __builtin_amdgcn_rcpf(1.0f + __expf(-z)); }


struct GemmDesc {
    const char* A; const char* B; char* C; const float* bias;
    unsigned aZ1, aZ2, bZ1, bZ2, aTile, bTile, cZ1, cZ2;
    unsigned aCh, bCh, cCh;
    int nM, nN, nZ, zdiv, K, lda, ldb, ldc, epi, gelu_pn, bhalf;
    unsigned mper, mnig, mgsz, mzdiv, padm;
};
struct Params {
    const float* in[27];
    float* out;
    bf16_t* wp[14];
    unsigned char* R1;
    float* c8sp;
    bf16_t* xr;
    float* edge;
    unsigned* bar;
    int CB, nch;
    unsigned char kind[32]; unsigned char arg[32];
    GemmDesc g[20];
};
enum { WP_FNET = 0, WP_IN, WP_GATE, WP_LOUT, WP_Q, WP_KV, WP_O, WP_UP, WP_DOWN, WP_CS, WP_DFTA, WP_MN, WP_R0, WP_PAD };
enum { K_GEMM = 0, K_PROLOGUE, K_RMS_IN, K_RMS_XA, K_RMS_FFN, K_RMS_MIX1, K_SOFTMAX, K_FFNCONV, K_FFNFIX, K_LRU, K_LRUCONV, K_SCAN, K_FINAL };
enum { E_BF16 = 0, E_F32, E_RESID, E_GATE, E_SOFTMAX, E_FFN, E_DFT };

struct Unit { const char* A; const char* B; int pm, pn, z1, z2; };

__device__ __forceinline__ void epi_bf16(const f32x4 (&acc)[2][2][4][2], const Unit& u, char* Cb, unsigned cZ1, unsigned cZ2, int ldc, int gelu_pn, int wr, int wc, int fr, int fq) {
    bf16_t* base = (bf16_t*)(Cb + (size_t)u.z1 * cZ1 + (size_t)u.z2 * cZ2) + (long)(u.pm * BM + wr * 64 + fr) * ldc + u.pn * BM + wc * 32 + 8 * fq;
    const bool g = u.pn < gelu_pn;
#pragma unroll
    for (int ai = 0; ai < 2; ++ai)
#pragma unroll
        for (int m = 0; m < 4; ++m) { bf16_t* rowp = base + (long)(ai * HALF + m * 16) * ldc;
#pragma unroll
            for (int bj = 0; bj < 2; ++bj) { f32x4 v0 = acc[ai][bj][m][0], v1 = acc[ai][bj][m][1];
                if (g) {
                    const f32x2 a = gelu_tanh2((f32x2){v0[0], v0[1]}), b = gelu_tanh2((f32x2){v0[2], v0[3]}), c = gelu_tanh2((f32x2){v1[0], v1[1]}), d = gelu_tanh2((f32x2){v1[2], v1[3]});
                    v0 = (f32x4){a.x, a.y, b.x, b.y}; v1 = (f32x4){c.x, c.y, d.x, d.y}; }
                u32x4 w; w.x = cvt_pk_bf16(v0[0], v0[1]); w.y = cvt_pk_bf16(v0[2], v0[3]); w.z = cvt_pk_bf16(v1[0], v1[1]); w.w = cvt_pk_bf16(v1[2], v1[3]);
                *(u32x4*)(rowp + bj * HALF) = w; } }
}
__device__ __forceinline__ void epi_f32(const f32x4 (&acc)[2][2][4][2], const Unit& u, char* Cb, unsigned cZ1, unsigned cZ2, int ldc, int wr, int wc, int fr, int fq) {
    float* base = (float*)(Cb + (size_t)u.z1 * cZ1 + (size_t)u.z2 * cZ2) + (long)(u.pm * BM + wr * 64 + fr) * ldc + u.pn * BM + wc * 32 + 4 * fq;
#pragma unroll
    for (int ai = 0; ai < 2; ++ai)
#pragma unroll
        for (int m = 0; m < 4; ++m) { float* rowp = base + (long)(ai * HALF + m * 16) * ldc;
#pragma unroll
            for (int bj = 0; bj < 2; ++bj)
#pragma unroll
                for (int n = 0; n < 2; ++n) *(f32x4*)(rowp + bj * HALF + n * 16) = acc[ai][bj][m][n]; }
}
__device__ __forceinline__ void epi_resid(const f32x4 (&acc)[2][2][4][2], const Unit& u, char* Cb, int ldc, const float* bias, int wr, int wc, int fr, int fq) {
    const int col0 = u.pn * BM + wc * 32 + 8 * fq;
    bf16_t* base = (bf16_t*)Cb + (long)(u.pm * BM + wr * 64 + fr) * ldc + col0;
#pragma unroll
    for (int bj = 0; bj < 2; ++bj) {
        const f32x4 b0 = bias ? *(const f32x4*)(bias + col0 + bj * HALF) : (f32x4){0.f, 0.f, 0.f, 0.f};
        const f32x4 b1 = bias ? *(const f32x4*)(bias + col0 + bj * HALF + 4) : (f32x4){0.f, 0.f, 0.f, 0.f};
#pragma unroll
        for (int ai = 0; ai < 2; ++ai)
#pragma unroll
            for (int m = 0; m < 4; ++m) { u32x4* q = (u32x4*)(base + (long)(ai * HALF + m * 16) * ldc + bj * HALF);
                const u32x4 x = *q; const f32x4 a0 = acc[ai][bj][m][0], a1 = acc[ai][bj][m][1];
                u32x4 w;
                w.x = cvt_pk_bf16(bflo(x.x) + a0[0] + b0[0], bfhi(x.x) + a0[1] + b0[1]); w.y = cvt_pk_bf16(bflo(x.y) + a0[2] + b0[2], bfhi(x.y) + a0[3] + b0[3]);
                w.z = cvt_pk_bf16(bflo(x.z) + a1[0] + b1[0], bfhi(x.z) + a1[1] + b1[1]); w.w = cvt_pk_bf16(bflo(x.w) + a1[2] + b1[2], bfhi(x.w) + a1[3] + b1[3]);
                *q = w; } }
}

__device__ __forceinline__ void epi_softmax(const f32x4 (&acc)[2][2][4][2], const Unit& u, char* Cb, unsigned cZ1, unsigned cZ2, int ldc, LAS float* rs, int wr, int wc, int fr, int fq) {
#pragma unroll
    for (int ai = 0; ai < 2; ++ai)
#pragma unroll
        for (int m = 0; m < 4; ++m) { float s = 0.f;
#pragma unroll
            for (int bj = 0; bj < 2; ++bj)
#pragma unroll
                for (int n = 0; n < 2; ++n)
#pragma unroll
                    for (int j = 0; j < 4; ++j) s += __expf(acc[ai][bj][m][n][j]);
            s += __shfl_xor(s, 16, 64); s += __shfl_xor(s, 32, 64);
            if (fq == 0) rs[((wr * 128 + ai * 64 + m * 16 + fr) << 2) + wc] = s; }
    asm volatile("s_waitcnt lgkmcnt(0)" ::: "memory");
    __builtin_amdgcn_s_barrier();
    __builtin_amdgcn_sched_barrier(0);
    asm volatile("" : "+s"(ldc) :: "memory");
    bf16_t* base = (bf16_t*)(Cb + (size_t)u.z1 * cZ1 + (size_t)u.z2 * cZ2) + (long)(u.pm * BM + wr * 64 + fr) * ldc + u.pn * BM + wc * 32 + 8 * fq;
#pragma unroll
    for (int ai = 0; ai < 2; ++ai)
#pragma unroll
        for (int m = 0; m < 4; ++m) {
            const f32x4 t = *(const LAS f32x4*)&rs[(wr * 128 + ai * 64 + m * 16 + fr) << 2];
            const float lg = __logf(t[0] + t[1] + t[2] + t[3]);
            bf16_t* rowp = base + (long)(ai * HALF + m * 16) * ldc;
#pragma unroll
            for (int bj = 0; bj < 2; ++bj) { f32x4 v0, v1;
#pragma unroll
                for (int j = 0; j < 4; ++j) { v0[j] = __expf(acc[ai][bj][m][0][j] - lg); v1[j] = __expf(acc[ai][bj][m][1][j] - lg); }
                u32x4 w; w.x = cvt_pk_bf16(v0[0], v0[1]); w.y = cvt_pk_bf16(v0[2], v0[3]); w.z = cvt_pk_bf16(v1[0], v1[1]); w.w = cvt_pk_bf16(v1[2], v1[3]);
                *(u32x4*)(rowp + bj * HALF) = w; } }
}

__device__ __forceinline__ float dpp_ror1(float x) { return __builtin_bit_cast(float, __builtin_amdgcn_mov_dpp(__builtin_bit_cast(int, x), 0x121, 0xf, 0xf, true)); }
__device__ __forceinline__ float dpp_rol1(float x) { return __builtin_bit_cast(float, __builtin_amdgcn_mov_dpp(__builtin_bit_cast(int, x), 0x12F, 0xf, 0xf, true)); }
__device__ __forceinline__ void epi_ffn(const f32x4 (&acc)[2][2][4][2], const Unit& u, char* Cb, const float* __restrict__ cw, const float* __restrict__ cb, float* __restrict__ edge, long edgeN,
                                        LAS float* E, int wr, int wc, int fr, int fq) {
    const int cl = wc * 32 + 4 * fq;
#pragma unroll
    for (int ai = 0; ai < 2; ++ai)
#pragma unroll
        for (int n = 0; n < 2; ++n) {
            if (fr == 0)  *(LAS f32x4*)&E[((wr * 2 + ai) * 2 + 0) * 128 + cl + 16 * n] = acc[ai][0][0][n];
            if (fr == 15) *(LAS f32x4*)&E[((wr * 2 + ai) * 2 + 1) * 128 + cl + 16 * n] = acc[ai][0][3][n];
        }
    asm volatile("s_waitcnt lgkmcnt(0)" ::: "memory");
    __builtin_amdgcn_s_barrier();
    __builtin_amdgcn_s_barrier();
    __builtin_amdgcn_sched_barrier(0);
    const int f0 = u.pn * 128 + cl;
    bf16_t* hbase = (bf16_t*)Cb + (long)(u.pm * BM + wr * 64 + fr) * DFF + f0;
#pragma unroll
    for (int n = 0; n < 2; ++n) {
        const f32x4 w0 = *(const f32x4*)(cw + f0 + 16 * n), w1 = *(const f32x4*)(cw + DFF + f0 + 16 * n), w2 = *(const f32x4*)(cw + 2 * DFF + f0 + 16 * n), bb = *(const f32x4*)(cb + f0 + 16 * n);
#pragma unroll
        for (int ai = 0; ai < 2; ++ai) {
            const f32x4 zero = {0.f, 0.f, 0.f, 0.f};
            f32x4 bup, bdn;
            if (wr == 1) bup = *(const LAS f32x4*)&E[((0 * 2 + ai) * 2 + 1) * 128 + cl + 16 * n];
            else if (ai == 1) bup = *(const LAS f32x4*)&E[((1 * 2 + 0) * 2 + 1) * 128 + cl + 16 * n];
            else bup = zero;
            if (wr == 0) bdn = *(const LAS f32x4*)&E[((1 * 2 + ai) * 2 + 0) * 128 + cl + 16 * n];
            else if (ai == 0) bdn = *(const LAS f32x4*)&E[((0 * 2 + 1) * 2 + 0) * 128 + cl + 16 * n];
            else bdn = zero;
            f32x4 r1[4], l1[4];
#pragma unroll
            for (int m = 0; m < 4; ++m)
#pragma unroll
                for (int j = 0; j < 4; ++j) { r1[m][j] = dpp_ror1(acc[ai][0][m][n][j]); l1[m][j] = dpp_rol1(acc[ai][0][m][n][j]); }
#pragma unroll
            for (int m = 0; m < 4; ++m) {
                const f32x4 g = acc[ai][0][m][n], v = acc[ai][1][m][n];
                const f32x4 upw = (m > 0) ? r1[m > 0 ? m - 1 : 0] : bup, dnw = (m < 3) ? l1[m < 3 ? m + 1 : 3] : bdn;
                f32x4 cv; float o[4];
#pragma unroll
                for (int jp = 0; jp < 2; ++jp) {
                    f32x2 up2, dn2;
                    up2.x = (fr == 0) ? upw[2 * jp] : r1[m][2 * jp]; up2.y = (fr == 0) ? upw[2 * jp + 1] : r1[m][2 * jp + 1];
                    dn2.x = (fr == 15) ? dnw[2 * jp] : l1[m][2 * jp]; dn2.y = (fr == 15) ? dnw[2 * jp + 1] : l1[m][2 * jp + 1];
                    const f32x2 g2 = {g[2 * jp], g[2 * jp + 1]}, v2 = {v[2 * jp], v[2 * jp + 1]};
                    const f32x2 w0p = {w0[2 * jp], w0[2 * jp + 1]}, w1p = {w1[2 * jp], w1[2 * jp + 1]}, w2p = {w2[2 * jp], w2[2 * jp + 1]}, bbp = {bb[2 * jp], bb[2 * jp + 1]};
                    const f32x2 c2 = w0p * up2 + (w1p * g2 + (w2p * dn2 + bbp));
                    const f32x2 o2 = gelu_tanh2(c2) * v2;
                    cv[2 * jp] = c2.x; cv[2 * jp + 1] = c2.y; o[2 * jp] = o2.x; o[2 * jp + 1] = o2.y;
                }
                u32x2 w; w.x = cvt_pk_bf16(o[0], o[1]); w.y = cvt_pk_bf16(o[2], o[3]);
                *(u32x2*)(hbase + (long)(ai * HALF + m * 16) * DFF + 16 * n) = w;
                if (ai == 0 && m == 0 && wr == 0 && fr == 0) {
                    float* e0 = edge + ((long)u.pm * 2 + 0) * DFF + f0 + 16 * n;
                    *(f32x4*)e0 = g; *(f32x4*)(e0 + edgeN) = cv; *(f32x4*)(e0 + 2 * edgeN) = v; }
                if (ai == 1 && m == 3 && wr == 1 && fr == 15) {
                    float* e1 = edge + ((long)u.pm * 2 + 1) * DFF + f0 + 16 * n;
                    *(f32x4*)e1 = g; *(f32x4*)(e1 + edgeN) = cv; *(f32x4*)(e1 + 2 * edgeN) = v; }
            }
        }
    }
}

__device__ __forceinline__ void epi_dft(const f32x4 (&acc)[2][2][4][2], const Unit& u, char* Cb, unsigned cZ1, int wr, int wc, int fr, int fq) {
    asm volatile("" : "+v"(fq), "+v"(fr));
    bf16_t* fb = (bf16_t*)(Cb + (size_t)u.z1 * cZ1) + u.pn * BM;
    const int r0 = u.pm * BM + wr * 64 + fr;
#pragma unroll
    for (int ai = 0; ai < 2; ++ai)
#pragma unroll
        for (int m = 0; m < 4; ++m) {
            const int s = r0 + ai * HALF + m * 16;
            bf16_t* rowp = fb + (long)s * DM;
            bf16_t* mir = fb + (long)(SEQ - s) * DM;
#pragma unroll
            for (int bj = 0; bj < 2; ++bj) {
                const int c0 = bj * HALF + wc * 32 + 8 * fq;
                const f32x4 v0 = acc[ai][bj][m][0], v1 = acc[ai][bj][m][1];
                u32x4 w; w.x = cvt_pk_bf16(v0[0], v0[1]); w.y = cvt_pk_bf16(v0[2], v0[3]); w.z = cvt_pk_bf16(v1[0], v1[1]); w.w = cvt_pk_bf16(v1[2], v1[3]);
                *(u32x4*)(rowp + c0) = w;
                if (s != 0) {
                    bf16_t* mg = mir + (248 - c0);
                    mg[1] = (bf16_t)(w.w >> 16);
                    *(unsigned*)(mg + 2) = cvt_pk_bf16(v1[2], v1[1]);
                    u32x2 t; t.x = cvt_pk_bf16(v1[0], v0[3]); t.y = cvt_pk_bf16(v0[2], v0[1]);
                    *(u32x2*)(mg + 4) = t;
                    mir[(256 - c0) & 255] = (bf16_t)(w.x & 0xffffu);
                }
            }
        }
}
__device__ __forceinline__ void epi_gate(const f32x4 (&acc)[2][2][4][2], const Unit& u, const bf16_t* cbuf, unsigned* LB, const float* b_a, const float* b_i, const float* c8sp, long Tc,
                                         int wr, int wc, int fr, int fq) {
    const int e = u.z1, h = u.z2;
#pragma unroll
    for (int n = 0; n < 2; ++n) {
        const int ch = h * 128 + wc * 32 + 8 * fq + 4 * n;
        const f32x4 ba = *(const f32x4*)(b_a + e * DRNN + ch), bi = *(const f32x4*)(b_i + e * DRNN + ch), sp = *(const f32x4*)(c8sp + e * DRNN + ch);
#pragma unroll
        for (int ai = 0; ai < 2; ++ai)
#pragma unroll
            for (int m = 0; m < 4; ++m) {
                const long row = (long)u.pm * BM + ai * HALF + wr * 64 + m * 16 + fr;
                const u32x2 cw = *(const u32x2*)(cbuf + row * DRNN + ch);
                const float cv[4] = {bflo(cw.x), bfhi(cw.x), bflo(cw.y), bfhi(cw.y)};
                u32x4 w;
#pragma unroll
                for (int j = 0; j < 4; ++j) {
                    const float r = sigmoidf(acc[ai][0][m][n][j] + ba[j]);
                    const float ig = sigmoidf(acc[ai][1][m][n][j] + bi[j]);
                    const float la = -sp[j] * r;
                    const float a2 = __expf(2.0f * la);
                    w[j] = cvt_pk_bf16(la, __builtin_sqrtf(fmaxf(1.0f - a2, 0.f)) * ig * cv[j]);
                }
                *(u32x4*)(LB + ((long)e * Tc + row) * DRNN + ch) = w;
            }
    }
}

__device__ __forceinline__ void ffn_fix_tile(bf16_t* __restrict__ H, const int pm, const int nMt, const float* __restrict__ edge, const float* __restrict__ cw, const int tid) {
    const long edgeN = (long)nMt * 2 * DFF; const int sp = pm & 7;
    for (int i = tid; i < 2 * (DFF / 4); i += 512) {
        const int e = i / (DFF / 4), f = (i - e * (DFF / 4)) * 4;
        if ((e == 0 && sp == 0) || (e == 1 && sp == 7)) continue;
        const float* me = edge + ((long)pm * 2 + e) * DFF + f;
        const f32x4 part = *(const f32x4*)(me + edgeN), v = *(const f32x4*)(me + 2 * edgeN);
        const f32x4 gn = e == 0 ? *(const f32x4*)(edge + ((long)(pm - 1) * 2 + 1) * DFF + f) : *(const f32x4*)(edge + ((long)(pm + 1) * 2 + 0) * DFF + f);
        const f32x4 w = *(const f32x4*)(cw + (e == 0 ? 0 : 2 * DFF) + f);
        float o[4];
#pragma unroll
        for (int j = 0; j < 4; ++j) o[j] = gelu_tanh(part[j] + w[j] * gn[j]) * v[j];
        u32x2 ww; ww.x = cvt_pk_bf16(o[0], o[1]); ww.y = cvt_pk_bf16(o[2], o[3]);
        *(u32x2*)(H + ((long)pm * BM + (e == 0 ? 0 : 255)) * DFF + f) = ww;
    }
}
__device__ __forceinline__ void block_seam();
__device__ __forceinline__ void gemm_phase(const int bid, const int nblk, LAS unsigned char* lds, const int garg, const int chunk, const Params& p) {
    const GemmDesc& d = p.g[garg];
    const int tid = tid_(), wid = __builtin_amdgcn_readfirstlane(tid >> 6), lane = tid & 63, wr = wid >> 2, wc = wid & 3, fr = lane & 15, fq = lane >> 4;
    const int K = d.K, lda = d.lda, ldb = d.ldb, epi = d.epi, nt = K / BK;
    const int nM = d.nM, nN = d.nN, zdiv = d.zdiv, nwg = nM * nN * d.nZ;
    const char* Ab = d.A + (size_t)chunk * d.aCh; const char* Bb = d.B + (size_t)chunk * d.bCh;
    const unsigned aZ1 = d.aZ1, aZ2 = d.aZ2, bZ1 = d.bZ1, bZ2 = d.bZ2, aTile = d.aTile, bTile = d.bTile;
    const unsigned mper = d.mper, mnig = d.mnig, mgsz = d.mgsz, mzdiv = d.mzdiv; const bool rev = (d.padm & 1u) != 0u;
    const int per = nM * nN, nig = 8 * nN, gsz = nM < 8 ? nM : 8, q8 = nwg >> 3, r8 = nwg & 7;
    auto next = [&](int i, Unit& u) -> bool {
        const long L = (long)i * nblk + bid; if (L >= nwg) return false;
        int w = (int)L; { const int xcd = w & 7; int off = w >> 3; const int cntx = xcd < r8 ? q8 + 1 : q8;
            if (rev) off = cntx - 1 - off;
            w = (xcd < r8 ? xcd * (q8 + 1) : r8 * (q8 + 1) + (xcd - r8) * q8) + off; }
        const int z = (int)__umulhi((unsigned)w, mper), loc = w - z * per;
        const int gid = (int)__umulhi((unsigned)loc, mnig), lr = loc - gid * nig;
        const int pn = (int)__umulhi((unsigned)lr, mgsz), pm = gid * 8 + lr - pn * gsz;
        const int z1 = zdiv == 1 ? z : (int)__umulhi((unsigned)z, mzdiv), z2 = z - z1 * zdiv;
        u.A = Ab + (size_t)z1 * aZ1 + (size_t)z2 * aZ2 + (size_t)pm * aTile; u.B = Bb + (size_t)z1 * bZ1 + (size_t)z2 * bZ2 + (size_t)pn * bTile;
        u.pm = pm; u.pn = pn; u.z1 = z1; u.z2 = z2; return true;
    };
    unsigned voffA[2], voffB[2];
#pragma unroll
    for (int i = 0; i < 2; ++i) { int R, C; stage_rc(tid * 16 + i * 8192, R, C); const int Rb = (epi != E_F32 && epi != E_FFN) ? ((R & ~31) + perm32(R & 31)) : R;
        voffA[i] = (unsigned)(R * lda + C) * 2u; voffB[i] = (unsigned)(Rb * ldb + C) * 2u; }
    const size_t kstep = (size_t)(BK * 2);
    const size_t hstepA = (size_t)HALF * lda * 2, hstepB = (size_t)d.bhalf * ldb * 2;
    const unsigned ldsw = (unsigned)wid * 1024u;
    const int aoff = lds_byte(wr * 64 + fr, fq * 8), boff = lds_byte(wc * 32 + fr, fq * 8);
#define PG8_SA(b, h) (((b) * 2 + (h)) * HTB)
#define PG8_SB(b, h) ((4 + (b) * 2 + (h)) * HTB)
#define PG8_STAGE(bufoff, gbase, voff) do { _Pragma("unroll") for (int _i = 0; _i < 2; ++_i) \
        __builtin_amdgcn_global_load_lds((const unsigned*)((const char*)(gbase) + (voff)[_i]), (LAS unsigned*)(lds + (bufoff) + ldsw + _i * 8192), 16, 0, 0); } while (0)
#define PG8_LDA(dst, b, h) do { _Pragma("unroll") for (int m = 0; m < 4; ++m) _Pragma("unroll") for (int k = 0; k < 2; ++k) dst[m][k] = *(const LAS bf16x8*)(lds + PG8_SA(b, h) + aoff + m * 2048 + k * 1024); } while (0)
#define PG8_LDB(dst, b, h) do { _Pragma("unroll") for (int n = 0; n < 2; ++n) _Pragma("unroll") for (int k = 0; k < 2; ++k) dst[n][k] = *(const LAS bf16x8*)(lds + PG8_SB(b, h) + boff + n * 2048 + k * 1024); } while (0)
#define PG8_MMA(ai, bj, At, Bt) do { __builtin_amdgcn_s_setprio(1); _Pragma("unroll") for (int m = 0; m < 4; ++m) _Pragma("unroll") for (int n = 0; n < 2; ++n) _Pragma("unroll") for (int k = 0; k < 2; ++k) \
        acc[ai][bj][m][n] = __builtin_amdgcn_mfma_f32_16x16x32_bf16(Bt[n][k], At[m][k], acc[ai][bj][m][n], 0, 0, 0); __builtin_amdgcn_s_setprio(0); } while (0)
#define PG8_WAIT_V(n) asm volatile("s_waitcnt vmcnt(" #n ")" ::: "memory")
#define PG8_WAIT_L(n) asm volatile("s_waitcnt lgkmcnt(" #n ")" ::: "memory")
#define PG8_BAR __builtin_amdgcn_s_barrier()
#define PG8_SCHED __builtin_amdgcn_sched_barrier(0)
    Unit cur, nxt; int ui = 0;
    if (!next(0, cur)) return;
    f32x4 acc[2][2][4][2];
#pragma unroll
    for (int a = 0; a < 2; ++a)
#pragma unroll
        for (int b = 0; b < 2; ++b)
#pragma unroll
            for (int m = 0; m < 4; ++m)
#pragma unroll
                for (int n = 0; n < 2; ++n) acc[a][b][m][n] = (f32x4){0.f, 0.f, 0.f, 0.f};
    bf16x8 At[4][2], B0[2][2], B1[2][2];
    const char* cA = cur.A; const char* cB = cur.B;
    PG8_STAGE(PG8_SB(0, 0), cB, voffB); PG8_STAGE(PG8_SA(0, 0), cA, voffA); PG8_STAGE(PG8_SB(0, 1), cB + hstepB, voffB); PG8_STAGE(PG8_SA(0, 1), cA + hstepA, voffA);
    if (wr == 1) PG8_BAR;
    PG8_WAIT_V(4); PG8_BAR;
    PG8_STAGE(PG8_SB(1, 0), cB + kstep, voffB); PG8_STAGE(PG8_SA(1, 0), cA + kstep, voffA); PG8_STAGE(PG8_SB(1, 1), cB + hstepB + kstep, voffB);
    PG8_WAIT_V(6); PG8_BAR;
    for (;;) {
        const bool has_next = next(ui + 1, nxt);
        const char* nA = has_next ? nxt.A : cA; const char* nB = has_next ? nxt.B : cB;
        for (int t = 0; t < nt; t += 2) {
            const bool last = (t == nt - 2);
            const char* a1 = cA + (size_t)(t + 1) * kstep;
            const char* a2 = last ? nA : cA + (size_t)(t + 2) * kstep; const char* b2 = last ? nB : cB + (size_t)(t + 2) * kstep;
            const char* a3 = a2 + kstep; const char* b3 = b2 + kstep;
            PG8_LDB(B0, 0, 0); PG8_SCHED; PG8_LDA(At, 0, 0); PG8_STAGE(PG8_SA(1, 1), a1 + hstepA, voffA);
            PG8_WAIT_L(8); PG8_BAR; PG8_WAIT_L(0); PG8_MMA(0, 0, At, B0); PG8_BAR; PG8_SCHED;
            PG8_LDB(B1, 0, 1); PG8_STAGE(PG8_SB(0, 0), b2, voffB);
            PG8_BAR; PG8_WAIT_L(0); PG8_MMA(0, 1, At, B1); PG8_BAR;
            PG8_LDA(At, 0, 1); PG8_STAGE(PG8_SA(0, 0), a2, voffA);
            PG8_BAR; PG8_WAIT_L(0); PG8_MMA(1, 0, At, B0); PG8_BAR; PG8_SCHED;
            PG8_STAGE(PG8_SB(0, 1), b2 + hstepB, voffB);
            PG8_WAIT_V(6); PG8_BAR; PG8_MMA(1, 1, At, B1); PG8_BAR;
            PG8_LDB(B0, 1, 0); PG8_SCHED; PG8_LDA(At, 1, 0); PG8_STAGE(PG8_SA(0, 1), a2 + hstepA, voffA);
            PG8_WAIT_L(8); PG8_BAR; PG8_WAIT_L(0); PG8_MMA(0, 0, At, B0); PG8_BAR; PG8_SCHED;
            PG8_LDB(B1, 1, 1); PG8_STAGE(PG8_SB(1, 0), b3, voffB);
            PG8_BAR; PG8_WAIT_L(0); PG8_MMA(0, 1, At, B1); PG8_BAR;
            PG8_LDA(At, 1, 1); PG8_STAGE(PG8_SA(1, 0), a3, voffA);
            PG8_BAR; PG8_WAIT_L(0); PG8_MMA(1, 0, At, B0); PG8_BAR; PG8_SCHED;
            PG8_STAGE(PG8_SB(1, 1), b3 + hstepB, voffB);
            PG8_WAIT_V(6); PG8_BAR; PG8_MMA(1, 1, At, B1); PG8_BAR;
        }
        {
            int zE; asm volatile("s_mov_b32 %0, 0" : "=s"(zE));
            const GemmDesc& de = p.g[garg + zE];
            char* Cb = de.C + (size_t)chunk * de.cCh;
            if (epi == E_BF16) epi_bf16(acc, cur, Cb, de.cZ1, de.cZ2, de.ldc, de.gelu_pn, wr, wc, fr, fq);
            else if (epi == E_RESID) epi_resid(acc, cur, Cb, de.ldc, de.bias, wr, wc, fr, fq);
            else if (epi == E_F32) epi_f32(acc, cur, Cb, de.cZ1, de.cZ2, de.ldc, wr, wc, fr, fq);
            else if (epi == E_DFT) epi_dft(acc, cur, Cb, de.cZ1, wr, wc, fr, fq);
            else if (epi == E_FFN) { const int layer = de.gelu_pn; epi_ffn(acc, cur, Cb, p.in[23 + zE] + layer * 3 * DFF, p.in[24 + zE] + layer * DFF, p.edge + zE, (long)de.nM * 2 * DFF, (LAS float*)(lds + STAGE_BYTES), wr, wc, fr, fq); }
            else if (epi == E_SOFTMAX) epi_softmax(acc, cur, Cb, de.cZ1, de.cZ2, de.ldc, (LAS float*)(lds + STAGE_BYTES), wr, wc, fr, fq);
            else { const long Tc = (long)(p.CB + zE) * SEQ; epi_gate(acc, cur, (const bf16_t*)(de.A + (size_t)chunk * de.aCh), (unsigned*)Cb, p.in[11 + zE], p.in[13 + zE], p.c8sp + zE, Tc, wr, wc, fr, fq); }
        }
        if (!has_next) break;
#pragma unroll
        for (int a = 0; a < 2; ++a)
#pragma unroll
            for (int b = 0; b < 2; ++b)
#pragma unroll
                for (int m = 0; m < 4; ++m)
#pragma unroll
                    for (int n = 0; n < 2; ++n) acc[a][b][m][n] = (f32x4){0.f, 0.f, 0.f, 0.f};
        cur = nxt; cA = nA; cB = nB; ++ui;
    }
    PG8_WAIT_V(0);
    if (wr == 0) PG8_BAR;
    PG8_BAR;
#undef PG8_SA
#undef PG8_SB
#undef PG8_STAGE
#undef PG8_LDA
#undef PG8_LDB
#undef PG8_MMA
#undef PG8_WAIT_V
#undef PG8_WAIT_L
#undef PG8_BAR
#undef PG8_SCHED
}

__device__ void transpose_job(const int bid, const int nblk, float* tile, const float* __restrict__ src, bf16_t* __restrict__ dst, int K, int N, int nb, long dstB, float scale) {
    const int tk = K / 64, tn = N / 64, per = tk * tn, tot = per * nb, tid = tid_();
    const int kk = tid >> 6, nn = tid & 63;
    float r[8];
    int t = bid;
    if (t < tot) { const int b = t / per, l = t - b * per, k0 = (l / tn) * 64, n0 = (l % tn) * 64; const float* s = src + (long)b * K * N;
#pragma unroll
        for (int i = 0; i < 8; ++i) r[i] = s[(long)(k0 + kk + 8 * i) * N + n0 + nn]; }
    while (t < tot) {
        const int b = t / per, l = t - b * per, k0 = (l / tn) * 64, n0 = (l % tn) * 64;
        bf16_t* d = dst + (long)b * dstB;
#pragma unroll
        for (int i = 0; i < 8; ++i) tile[(kk + 8 * i) * 65 + nn] = r[i];
        __syncthreads();
        const int t2 = t + nblk;
        if (t2 < tot) { const int b2 = t2 / per, l2 = t2 - b2 * per, k2 = (l2 / tn) * 64, n2 = (l2 % tn) * 64; const float* s2 = src + (long)b2 * K * N;
#pragma unroll
            for (int i = 0; i < 8; ++i) r[i] = s2[(long)(k2 + kk + 8 * i) * N + n2 + nn]; }
#pragma unroll
        for (int i = 0; i < 8; ++i) { const int n = kk + 8 * i, k = nn; d[(long)(n0 + n) * K + k0 + k] = f2bf(tile[k * 65 + n] * scale); }
        __syncthreads();
        t = t2;
    }
}

__device__ __forceinline__ float wave_sum(float v) {
#pragma unroll
    for (int o = 32; o > 0; o >>= 1) v += __shfl_xor(v, o, 64);
    return v;
}
__device__ __forceinline__ float wave_max(float v) {
#pragma unroll
    for (int o = 32; o > 0; o >>= 1) v = fmaxf(v, __shfl_xor(v, o, 64));
    return v;
}

__device__ void rms_phase(const int bid, const int nblk, long g0, long nrows, const float* __restrict__ src0, const float* __restrict__ src1, long split, const float* __restrict__ gain,
                          bf16_t* __restrict__ dst, bf16_t* __restrict__ cpy) {
    const int wid = tid_() >> 6, lane = tid_() & 63;
    f32x4 gv[4];
#pragma unroll
    for (int i = 0; i < 4; ++i) gv[i] = *(const f32x4*)(gain + i * 256 + lane * 4);
    const long stride = (long)nblk * 8;
    for (long r = (long)bid * 8 + wid; r < nrows; r += 2 * stride) {
        const long rr[2] = {r, r + stride};
        f32x4 v[2][4];
#pragma unroll
        for (int q = 0; q < 2; ++q) if (rr[q] < nrows) {
            const long gr = g0 + rr[q];
            const float* s = gr < split ? src0 + gr * DM : src1 + (gr - split) * DM;
#pragma unroll
            for (int i = 0; i < 4; ++i) v[q][i] = *(const f32x4*)(s + i * 256 + lane * 4);
        }
#pragma unroll
        for (int q = 0; q < 2; ++q) if (rr[q] < nrows) {
            float ss = 0.f;
#pragma unroll
            for (int i = 0; i < 4; ++i) ss += v[q][i][0] * v[q][i][0] + v[q][i][1] * v[q][i][1] + v[q][i][2] * v[q][i][2] + v[q][i][3] * v[q][i][3];
            ss = wave_sum(ss);
            const float rs = rsqrtf(ss * (1.0f / DM) + 1e-6f);
#pragma unroll
            for (int i = 0; i < 4; ++i) {
                u32x2 w; w.x = cvt_pk_bf16(v[q][i][0] * rs * gv[i][0], v[q][i][1] * rs * gv[i][1]); w.y = cvt_pk_bf16(v[q][i][2] * rs * gv[i][2], v[q][i][3] * rs * gv[i][3]);
                *(u32x2*)(dst + rr[q] * DM + i * 256 + lane * 4) = w;
                if (cpy) { u32x2 c; c.x = cvt_pk_bf16(v[q][i][0], v[q][i][1]); c.y = cvt_pk_bf16(v[q][i][2], v[q][i][3]); *(u32x2*)(cpy + rr[q] * DM + i * 256 + lane * 4) = c; }
            }
        }
    }
}
__device__ void rms_bf_phase(const int bid, const int nblk, long nrows, const bf16_t* __restrict__ X, const float* __restrict__ gain, bf16_t* __restrict__ dst) {
    const int wid = tid_() >> 6, lane = tid_() & 63;
    f32x4 gv[4];
#pragma unroll
    for (int i = 0; i < 2; ++i) { gv[2 * i] = *(const f32x4*)(gain + i * 512 + lane * 8); gv[2 * i + 1] = *(const f32x4*)(gain + i * 512 + lane * 8 + 4); }
    const long stride = (long)nblk * 8;
    for (long r = (long)bid * 8 + wid; r < nrows; r += 2 * stride) {
        const long rr[2] = {r, r + stride};
        u32x4 v[2][2];
#pragma unroll
        for (int q = 0; q < 2; ++q) if (rr[q] < nrows) {
#pragma unroll
            for (int i = 0; i < 2; ++i) v[q][i] = *(const u32x4*)(X + rr[q] * DM + i * 512 + lane * 8);
        }
#pragma unroll
        for (int q = 0; q < 2; ++q) if (rr[q] < nrows) {
            float f[16]; float ss = 0.f;
#pragma unroll
            for (int i = 0; i < 2; ++i)
#pragma unroll
                for (int k = 0; k < 4; ++k) { f[i * 8 + 2 * k] = bflo(v[q][i][k]); f[i * 8 + 2 * k + 1] = bfhi(v[q][i][k]); }
#pragma unroll
            for (int k = 0; k < 16; ++k) ss += f[k] * f[k];
            ss = wave_sum(ss);
            const float rs = rsqrtf(ss * (1.0f / DM) + 1e-6f);
#pragma unroll
            for (int i = 0; i < 2; ++i) {
                u32x4 w;
                w.x = cvt_pk_bf16(f[i * 8 + 0] * rs * gv[2 * i][0], f[i * 8 + 1] * rs * gv[2 * i][1]); w.y = cvt_pk_bf16(f[i * 8 + 2] * rs * gv[2 * i][2], f[i * 8 + 3] * rs * gv[2 * i][3]);
                w.z = cvt_pk_bf16(f[i * 8 + 4] * rs * gv[2 * i + 1][0], f[i * 8 + 5] * rs * gv[2 * i + 1][1]); w.w = cvt_pk_bf16(f[i * 8 + 6] * rs * gv[2 * i + 1][2], f[i * 8 + 7] * rs * gv[2 * i + 1][3]);
                *(u32x4*)(dst + rr[q] * DM + i * 512 + lane * 8) = w;
            }
        }
    }
}
__device__ void final_norm_phase(const int bid, const int nblk, const bf16_t* __restrict__ X, float* __restrict__ y, long nrows, const float* __restrict__ gain) {
    const int wid = tid_() >> 6, lane = tid_() & 63;
    f32x4 gv[4];
#pragma unroll
    for (int i = 0; i < 2; ++i) { gv[2 * i] = *(const f32x4*)(gain + i * 512 + lane * 8); gv[2 * i + 1] = *(const f32x4*)(gain + i * 512 + lane * 8 + 4); }
    for (long r = (long)bid * 8 + wid; r < nrows; r += (long)nblk * 8) {
        u32x4 v[2];
#pragma unroll
        for (int i = 0; i < 2; ++i) v[i] = *(const u32x4*)(X + r * DM + i * 512 + lane * 8);
        float f[16]; float ss = 0.f;
#pragma unroll
        for (int i = 0; i < 2; ++i)
#pragma unroll
            for (int k = 0; k < 4; ++k) { f[i * 8 + 2 * k] = bflo(v[i][k]); f[i * 8 + 2 * k + 1] = bfhi(v[i][k]); }
#pragma unroll
        for (int k = 0; k < 16; ++k) ss += f[k] * f[k];
        ss = wave_sum(ss);
        const float rs = rsqrtf(ss * (1.0f / DM) + 1e-6f);
#pragma unroll
        for (int i = 0; i < 2; ++i) {
            f32x4 o0, o1;
#pragma unroll
            for (int j = 0; j < 4; ++j) { o0[j] = f[i * 8 + j] * rs * gv[2 * i][j]; o1[j] = f[i * 8 + 4 + j] * rs * gv[2 * i + 1][j]; }
            *(f32x4*)(y + r * DM + i * 512 + lane * 8) = o0; *(f32x4*)(y + r * DM + i * 512 + lane * 8 + 4) = o1;
        }
    }
}
__device__ void dft_row1024_job(const int bid, const int nblk, const bf16_t* __restrict__ YT, bf16_t* __restrict__ F, int CB) {
    const int wid = tid_() >> 6, lane = tid_() & 63;
    const int nrow = CB * DM;
    for (int r = bid * 8 + wid; r < nrow; r += nblk * 8) {
        const bf16_t* y = YT + (long)r * (2 * SEQ) + lane * 8;
        float s = 0.f;
#pragma unroll
        for (int i = 0; i < 4; ++i) { const u32x4 w = *(const u32x4*)(y + i * 512);
#pragma unroll
            for (int k = 0; k < 4; ++k) s += bflo(w[k]) - bfhi(w[k]); }
        s = wave_sum(s);
        if (lane == 0) { const int bi = r >> 10, gc = r & 1023; F[((long)bi * SEQ + 1024) * DM + gc] = f2bf(s * 0.022097086912f); }
    }
}
__device__ void softmax_phase(const int bid, const int nblk, const float* __restrict__ S, bf16_t* __restrict__ P, long nrh) {
    const int wid = tid_() >> 6, lane = tid_() & 63;
    for (long r = (long)bid * 8 + wid; r < nrh; r += (long)nblk * 8) {
        f32x4 v = *(const f32x4*)(S + r * 256 + lane * 4);
        float mx = wave_max(fmaxf(fmaxf(v[0], v[1]), fmaxf(v[2], v[3])));
        f32x4 e; for (int j = 0; j < 4; ++j) e[j] = __expf(v[j] - mx);
        const float inv = 1.0f / wave_sum(e[0] + e[1] + e[2] + e[3]);
        u32x2 w; w.x = cvt_pk_bf16(e[0] * inv, e[1] * inv); w.y = cvt_pk_bf16(e[2] * inv, e[3] * inv);
        *(u32x2*)(P + r * 256 + lane * 4) = w;
    }
}
__device__ void ffn_conv_phase(const int bid, const int nblk, bf16_t* __restrict__ GV, long Tc, const float* __restrict__ cw, const float* __restrict__ cb) {
    const long tot = (Tc / 4) * (DFF / 8);
    for (long i = (long)bid * 512 + tid_(); i < tot; i += (long)nblk * 512) {
        const long t4 = i / (DFF / 8); const int f = (int)(i - t4 * (DFF / 8)) * 8; const long t = t4 * 4; const int pos = (int)(t & (SEQ - 1));
        bf16_t* g = GV + t * (2 * DFF) + f;
        const u32x4 z = {0u, 0u, 0u, 0u};
        u32x4 gr[6], vr[4];
        gr[0] = pos > 0 ? *(const u32x4*)(g - 2 * DFF) : z;
#pragma unroll
        for (int q = 0; q < 4; ++q) { gr[q + 1] = *(const u32x4*)(g + (long)q * 2 * DFF); vr[q] = *(const u32x4*)(g + (long)q * 2 * DFF + DFF); }
        gr[5] = pos + 4 < SEQ ? *(const u32x4*)(g + (long)4 * 2 * DFF) : z;
        float w0[8], w1[8], w2[8], bb[8];
#pragma unroll
        for (int j = 0; j < 8; ++j) { w0[j] = cw[f + j]; w1[j] = cw[DFF + f + j]; w2[j] = cw[2 * DFF + f + j]; bb[j] = cb[f + j]; }
#pragma unroll
        for (int q = 0; q < 4; ++q) {
            float o[8];
#pragma unroll
            for (int j = 0; j < 8; ++j) {
                const unsigned a0 = gr[q][j >> 1], a1 = gr[q + 1][j >> 1], a2 = gr[q + 2][j >> 1], av = vr[q][j >> 1];
                const float x0 = (j & 1) ? bfhi(a0) : bflo(a0), x1 = (j & 1) ? bfhi(a1) : bflo(a1), x2 = (j & 1) ? bfhi(a2) : bflo(a2), xv = (j & 1) ? bfhi(av) : bflo(av);
                o[j] = gelu_tanh(x0 * w0[j] + x1 * w1[j] + x2 * w2[j] + bb[j]) * xv;
            }
            u32x4 w; w.x = cvt_pk_bf16(o[0], o[1]); w.y = cvt_pk_bf16(o[2], o[3]); w.z = cvt_pk_bf16(o[4], o[5]); w.w = cvt_pk_bf16(o[6], o[7]);
            *(u32x4*)(g + (long)q * 2 * DFF + DFF) = w;
        }
    }
}
__device__ void ffn_fix_phase(const int bid, const int nblk, bf16_t* __restrict__ H, int nMt, const float* __restrict__ edge, const float* __restrict__ cw) {
    const long edgeN = (long)nMt * 2 * DFF; const long tot = (long)nMt * 2 * (DFF / 4);
    for (long i = (long)bid * 512 + tid_(); i < tot; i += (long)nblk * 512) {
        const int pm = (int)(i / (2 * (DFF / 4))); const int rem = (int)(i - (long)pm * (2 * (DFF / 4))); const int e = rem / (DFF / 4), f = (rem - e * (DFF / 4)) * 4;
        const int sp = pm & 7;
        if ((e == 0 && sp == 0) || (e == 1 && sp == 7)) continue;
        const float* me = edge + ((long)pm * 2 + e) * DFF + f;
        const f32x4 part = *(const f32x4*)(me + edgeN), v = *(const f32x4*)(me + 2 * edgeN);
        const f32x4 gn = e == 0 ? *(const f32x4*)(edge + ((long)(pm - 1) * 2 + 1) * DFF + f) : *(const f32x4*)(edge + ((long)(pm + 1) * 2 + 0) * DFF + f);
        const f32x4 w = *(const f32x4*)(cw + (e == 0 ? 0 : 2 * DFF) + f);
        float o[4];
#pragma unroll
        for (int j = 0; j < 4; ++j) o[j] = gelu_tanh(part[j] + w[j] * gn[j]) * v[j];
        u32x2 ww; ww.x = cvt_pk_bf16(o[0], o[1]); ww.y = cvt_pk_bf16(o[2], o[3]);
        *(u32x2*)(H + ((long)pm * BM + (e == 0 ? 0 : 255)) * DFF + f) = ww;
    }
}
__device__ void lru_conv_phase(const int bid, const int nblk, const bf16_t* __restrict__ U, bf16_t* __restrict__ cbuf, long Tc, const float* __restrict__ cw, const float* __restrict__ cb) {
    const long tot = (Tc / 4) * (DRNN / 8);
    for (long i = (long)bid * 512 + tid_(); i < tot; i += (long)nblk * 512) {
        const long t4 = i / (DRNN / 8); const int f = (int)(i - t4 * (DRNN / 8)) * 8; const long t = t4 * 4; const int pos = (int)(t & (SEQ - 1));
        const bf16_t* g = U + t * (2 * DRNN) + DRNN + f;
        const u32x4 z = {0u, 0u, 0u, 0u};
        u32x4 rr[7];
        rr[0] = pos > 1 ? *(const u32x4*)(g - 4 * DRNN) : z; rr[1] = pos > 0 ? *(const u32x4*)(g - 2 * DRNN) : z;
#pragma unroll
        for (int q = 0; q < 4; ++q) rr[q + 2] = *(const u32x4*)(g + (long)q * 2 * DRNN);
        rr[6] = pos + 4 < SEQ ? *(const u32x4*)(g + (long)4 * 2 * DRNN) : z;
        float w0[8], w1[8], w2[8], w3[8], bb[8];
#pragma unroll
        for (int j = 0; j < 8; ++j) { w0[j] = cw[f + j]; w1[j] = cw[DRNN + f + j]; w2[j] = cw[2 * DRNN + f + j]; w3[j] = cw[3 * DRNN + f + j]; bb[j] = cb[f + j]; }
#pragma unroll
        for (int q = 0; q < 4; ++q) {
            float o[8];
#pragma unroll
            for (int j = 0; j < 8; ++j) {
                const unsigned a0 = rr[q][j >> 1], a1 = rr[q + 1][j >> 1], a2 = rr[q + 2][j >> 1], a3 = rr[q + 3][j >> 1];
                const float x0 = (j & 1) ? bfhi(a0) : bflo(a0), x1 = (j & 1) ? bfhi(a1) : bflo(a1), x2 = (j & 1) ? bfhi(a2) : bflo(a2), x3 = (j & 1) ? bfhi(a3) : bflo(a3);
                o[j] = x0 * w0[j] + x1 * w1[j] + x2 * w2[j] + x3 * w3[j] + bb[j];
            }
            u32x4 w; w.x = cvt_pk_bf16(o[0], o[1]); w.y = cvt_pk_bf16(o[2], o[3]); w.z = cvt_pk_bf16(o[4], o[5]); w.w = cvt_pk_bf16(o[6], o[7]);
            *(u32x4*)(cbuf + (t + q) * DRNN + f) = w;
        }
    }
}
__device__ void scan_phase(const int bid, const int nblk, bf16_t* __restrict__ U, const unsigned* __restrict__ LB, long Tc, int CB, float* sm) {
    const int wid = tid_() >> 6, lane = tid_() & 63;
    const int nitems = CB * (DRNN / 128);
    for (int it = bid; it < nitems; it += nblk) {
        const int bi = it / (DRNN / 128), cgp = it - bi * (DRNN / 128); const int ch = cgp * 128 + lane * 2;
        const long row0 = (long)bi * SEQ + wid * 256;
        const unsigned* lf = LB + row0 * DRNN + ch; const unsigned* lb = lf + Tc * DRNN;
        float Sf0 = 0.f, Sf1 = 0.f, Bf0 = 0.f, Bf1 = 0.f, Sb0 = 0.f, Sb1 = 0.f, Bb0 = 0.f, Bb1 = 0.f;
#pragma unroll 16
        for (int t = 0; t < 256; ++t) {
            const u32x2 w1 = *(const u32x2*)(lf + (long)t * DRNN);
            Bf0 = __expf(bflo(w1.x)) * Bf0 + bfhi(w1.x); Sf0 += bflo(w1.x); Bf1 = __expf(bflo(w1.y)) * Bf1 + bfhi(w1.y); Sf1 += bflo(w1.y);
            const int tb = 255 - t;
            const u32x2 w2 = *(const u32x2*)(lb + (long)tb * DRNN);
            Bb0 = __expf(bflo(w2.x)) * Bb0 + bfhi(w2.x); Sb0 += bflo(w2.x); Bb1 = __expf(bflo(w2.y)) * Bb1 + bfhi(w2.y); Sb1 += bflo(w2.y);
        }
        float* my = sm + (wid * 64 + lane) * 8;
        my[0] = __expf(Sf0); my[1] = Bf0; my[2] = __expf(Sb0); my[3] = Bb0; my[4] = __expf(Sf1); my[5] = Bf1; my[6] = __expf(Sb1); my[7] = Bb1;
        __syncthreads();
        float hf0 = 0.f, hb0 = 0.f, hf1 = 0.f, hb1 = 0.f;
        for (int s = 0; s < wid; ++s) { const float* o = sm + (s * 64 + lane) * 8; hf0 = o[0] * hf0 + o[1]; hf1 = o[4] * hf1 + o[5]; }
        for (int s = 7; s > wid; --s) { const float* o = sm + (s * 64 + lane) * 8; hb0 = o[2] * hb0 + o[3]; hb1 = o[6] * hb1 + o[7]; }
        __syncthreads();
        bf16_t* Ug = U + row0 * (2 * DRNN) + ch;
#pragma unroll 16
        for (int t = 0; t < 256; ++t) {
            const u32x2 w1 = *(const u32x2*)(lf + (long)t * DRNN);
            hf0 = __expf(bflo(w1.x)) * hf0 + bfhi(w1.x); hf1 = __expf(bflo(w1.y)) * hf1 + bfhi(w1.y);
            *(unsigned*)(Ug + (long)t * (2 * DRNN) + DRNN) = cvt_pk_bf16(hf0, hf1);
        }
#pragma unroll 16
        for (int t = 255; t >= 0; --t) {
            const u32x2 w2 = *(const u32x2*)(lb + (long)t * DRNN);
            hb0 = __expf(bflo(w2.x)) * hb0 + bfhi(w2.x); hb1 = __expf(bflo(w2.y)) * hb1 + bfhi(w2.y);
            const unsigned hfw = *(const unsigned*)(Ug + (long)t * (2 * DRNN) + DRNN), gw = *(const unsigned*)(Ug + (long)t * (2 * DRNN));
            *(unsigned*)(Ug + (long)t * (2 * DRNN)) = cvt_pk_bf16((bflo(hfw) + hb0) * bflo(gw), (bfhi(hfw) + hb1) * bfhi(gw));
        }
    }
}

__device__ void lru_fused_phase(const int bid, const int nblk, bf16_t* __restrict__ U, bf16_t* __restrict__ HF, const bf16_t* __restrict__ Wg, const float* __restrict__ cw, const float* __restrict__ cb,
                                const float* __restrict__ b_a, const float* __restrict__ b_i, const float* __restrict__ c8sp, int CB, unsigned char* smem) {
    constexpr int RS = 272;
    const int tid = tid_(), wid = tid >> 6, lane = tid & 63, fr = lane & 15, fq = lane >> 4;
    const int nitems = CB * 10;
    for (int it = bid; it < nitems; it += nblk) {
        const int bi = it / 10, h = it - bi * 10;
        const long rowb = (long)bi * SEQ;
        const int chl = 16 * wid + fr, ch = h * 128 + chl;
        const int sch = h * 128 + 2 * lane;
        float w0[2], w1[2], w2[2], w3[2], wb[2];
#pragma unroll
        for (int q = 0; q < 2; ++q) { w0[q] = cw[sch + q]; w1[q] = cw[DRNN + sch + q]; w2[q] = cw[2 * DRNN + sch + q]; w3[q] = cw[3 * DRNN + sch + q]; wb[q] = cb[sch + q]; }
        const bf16_t* recp = U + rowb * (2 * DRNN) + DRNN + sch;
        for (int e = 0; e < 2; ++e) {
            bf16x8 Bf[2][4];
#pragma unroll
            for (int g = 0; g < 2; ++g)
#pragma unroll
                for (int s = 0; s < 4; ++s) Bf[g][s] = *(const bf16x8*)(Wg + ((long)((e * 10 + h) * 256 + g * 128 + chl)) * 128 + 32 * s + 8 * fq);
            const float ba = b_a[e * DRNN + ch], bi_ = b_i[e * DRNN + ch], sp = c8sp[e * DRNN + ch];
            float hs = 0.f;
            unsigned xr[11];
            {
                const int k = e == 0 ? 0 : 31; const int p0 = 64 * k + 8 * wid - 2;
#pragma unroll
                for (int i = 0; i < 11; ++i) { const int pos = p0 + i; xr[i] = (pos >= 0 && pos < SEQ) ? *(const unsigned*)(recp + (long)pos * (2 * DRNN)) : 0u; }
#pragma unroll
                for (int r = 0; r < 8; ++r) {
                    const float c0 = wb[0] + w0[0] * bflo(xr[r]) + w1[0] * bflo(xr[r + 1]) + w2[0] * bflo(xr[r + 2]) + w3[0] * bflo(xr[r + 3]);
                    const float c1 = wb[1] + w0[1] * bfhi(xr[r]) + w1[1] * bfhi(xr[r + 1]) + w2[1] * bfhi(xr[r + 2]) + w3[1] * bfhi(xr[r + 3]);
                    *(unsigned*)(smem + (8 * wid + r) * RS + lane * 4) = cvt_pk_bf16(c0, c1);
                }
            }
            __syncthreads();
            for (int kk = 0; kk < 32; ++kk) {
                const int k = e == 0 ? kk : 31 - kk;
                unsigned char* buf = smem + (kk & 1) * (64 * RS);
                if (kk + 1 < 32) {
                    const int kn = e == 0 ? kk + 1 : 30 - kk; const int p0 = 64 * kn + 8 * wid - 2;
#pragma unroll
                    for (int i = 0; i < 11; ++i) { const int pos = p0 + i; xr[i] = (pos >= 0 && pos < SEQ) ? *(const unsigned*)(recp + (long)pos * (2 * DRNN)) : 0u; }
                }
#pragma unroll
                for (int rti = 0; rti < 4; ++rti) {
                    const int rt = e == 0 ? rti : 3 - rti;
                    const long grow = rowb + 64 * k + 16 * rt + 4 * fq;
                    unsigned short hfv[4], gtv[4];
                    if (e == 1) {
#pragma unroll
                        for (int j = 0; j < 4; ++j) { hfv[j] = HF[(grow + j) * DRNN + ch]; gtv[j] = U[(grow + j) * (2 * DRNN) + ch]; }
                    }
                    f32x4 za = {0.f, 0.f, 0.f, 0.f}, zi = {0.f, 0.f, 0.f, 0.f};
#pragma unroll
                    for (int s = 0; s < 4; ++s) {
                        const bf16x8 af = *(const bf16x8*)(buf + (16 * rt + fr) * RS + (32 * s + 8 * fq) * 2);
                        za = __builtin_amdgcn_mfma_f32_16x16x32_bf16(af, Bf[0][s], za, 0, 0, 0);
                        zi = __builtin_amdgcn_mfma_f32_16x16x32_bf16(af, Bf[1][s], zi, 0, 0, 0);
                    }
                    float av[4], bv[4];
#pragma unroll
                    for (int j = 0; j < 4; ++j) {
                        const float c = bf2f(*(const unsigned short*)(buf + (16 * rt + 4 * fq + j) * RS + chl * 2));
                        const float r = sigmoidf(za[j] + ba), ig = sigmoidf(zi[j] + bi_);
                        const float la = -sp * r;
                        av[j] = __expf(la);
                        bv[j] = __builtin_sqrtf(fmaxf(1.0f - av[j] * av[j], 0.f)) * ig * c;
                    }
                    float hl[4], pp[4];
                    if (e == 0) { hl[0] = bv[0]; pp[0] = av[0];
#pragma unroll
                        for (int j = 1; j < 4; ++j) { hl[j] = av[j] * hl[j - 1] + bv[j]; pp[j] = av[j] * pp[j - 1]; } }
                    else { hl[3] = bv[3]; pp[3] = av[3];
#pragma unroll
                        for (int j = 2; j >= 0; --j) { hl[j] = av[j] * hl[j + 1] + bv[j]; pp[j] = av[j] * pp[j + 1]; } }
                    const float Ag = e == 0 ? pp[3] : pp[0], Hg = e == 0 ? hl[3] : hl[0];
                    float A4[4], H4[4];
#pragma unroll
                    for (int f = 0; f < 4; ++f) { A4[f] = __shfl(Ag, fr + 16 * f, 64); H4[f] = __shfl(Hg, fr + 16 * f, 64); }
                    float carry, sN;
                    if (e == 0) { const float s0 = hs, s1 = A4[0] * s0 + H4[0], s2 = A4[1] * s1 + H4[1], s3 = A4[2] * s2 + H4[2]; sN = A4[3] * s3 + H4[3];
                        carry = fq == 0 ? s0 : (fq == 1 ? s1 : (fq == 2 ? s2 : s3)); }
                    else { const float t0 = hs, t1 = A4[3] * t0 + H4[3], t2 = A4[2] * t1 + H4[2], t3 = A4[1] * t2 + H4[1]; sN = A4[0] * t3 + H4[0];
                        carry = fq == 3 ? t0 : (fq == 2 ? t1 : (fq == 1 ? t2 : t3)); }
                    hs = sN;
#pragma unroll
                    for (int j = 0; j < 4; ++j) {
                        const float hv = hl[j] + pp[j] * carry;
                        if (e == 0) HF[(grow + j) * DRNN + ch] = f2bf(hv);
                        else U[(grow + j) * (2 * DRNN) + ch] = f2bf((bf2f(hfv[j]) + hv) * bf2f(gtv[j]));
                    }
                }
                if (kk + 1 < 32) {
                    unsigned char* nb = smem + ((kk + 1) & 1) * (64 * RS);
#pragma unroll
                    for (int r = 0; r < 8; ++r) {
                        const float c0 = wb[0] + w0[0] * bflo(xr[r]) + w1[0] * bflo(xr[r + 1]) + w2[0] * bflo(xr[r + 2]) + w3[0] * bflo(xr[r + 3]);
                        const float c1 = wb[1] + w0[1] * bfhi(xr[r]) + w1[1] * bfhi(xr[r + 1]) + w2[1] * bfhi(xr[r + 2]) + w3[1] * bfhi(xr[r + 3]);
                        *(unsigned*)(nb + (8 * wid + r) * RS + lane * 4) = cvt_pk_bf16(c0, c1);
                    }
                }
                __syncthreads();
            }
        }
    }
}

#define XB_TMO      128
#define XB_XCNT(j)  (256  + 64 * (j))
#define XB_XSUB(j)  (1280 + 64 * (j))
#define XB_XGEN(j)  (2304 + 64 * (j))
#define XB_TOP      3328
#define XB_TOPGEN   3392
#define XCD_BAR_WORDS 3456
#define XB_SPIN_CAP (1u << 22)
__device__ __forceinline__ unsigned xb_ld(unsigned* p)              { return __hip_atomic_load(p, __ATOMIC_RELAXED, __HIP_MEMORY_SCOPE_AGENT); }
__device__ __forceinline__ unsigned xb_add(unsigned* p, unsigned v) { return __hip_atomic_fetch_add(p, v, __ATOMIC_RELAXED, __HIP_MEMORY_SCOPE_AGENT); }
__device__ __forceinline__ unsigned xb_xcc_id() { return (unsigned)__builtin_amdgcn_s_getreg((3 << 11) | 20) & 0xFu; }
#define XB_SPIN(cond, bar) do { unsigned _sp = 0; while (cond) { __builtin_amdgcn_s_sleep(1); \
    if ((++_sp & 255u) == 0u) { if (xb_ld(&(bar)[XB_TMO])) break; if (_sp > XB_SPIN_CAP) { atomicAdd(&(bar)[XB_TMO], 1u); break; } } } } while (0)
__device__ __forceinline__ void xcd_barrier_complete(unsigned* bar, unsigned x, unsigned G, unsigned& nloc, unsigned& nx) {
    unsigned sum, cnt, mine, sp = 0u;
    for (;;) {
        sum = 0u; cnt = 0u; mine = 0u;
#pragma unroll
        for (unsigned j = 0; j < 16; ++j) { const unsigned c = xb_ld(&bar[XB_XCNT(j)]); sum += c; cnt += (c > 0u) ? 1u : 0u; mine = (j == x) ? c : mine; }
        if (sum == G) break;
        __builtin_amdgcn_s_sleep(1);
        if ((++sp & 255u) == 0u) { if (xb_ld(&bar[XB_TMO])) break; if (sp > XB_SPIN_CAP) { atomicAdd(&bar[XB_TMO], 1u); break; } }
    }
    nloc = mine > 0u ? mine : 1u; nx = cnt > 0u ? cnt : 1u;
}
__device__ __forceinline__ void xcd_barrier(unsigned* bar, volatile LAS unsigned* st, unsigned G) {
    asm volatile("s_waitcnt vmcnt(0)" ::: "memory");
    __syncthreads();
    if (tid_() == 0) {
        const unsigned x = xb_xcc_id();
        __builtin_amdgcn_s_waitcnt(0);
        unsigned nloc = st[0], nx = st[1];
        if (nloc == 0u) { xcd_barrier_complete(bar, x, G, nloc, nx); st[0] = nloc; st[1] = nx; }
        const unsigned old = xb_add(&bar[XB_XSUB(x)], 1u);
        const unsigned gen = old / nloc;
        if (old + 1u == (gen + 1u) * nloc) {
            __builtin_amdgcn_fence(__ATOMIC_RELEASE, "agent");
            asm volatile("s_waitcnt vmcnt(0)" ::: "memory");
            const unsigned og = xb_add(&bar[XB_TOP], 1u);
            const unsigned tg = og / nx;
            if (og + 1u == (tg + 1u) * nx) xb_add(&bar[XB_TOPGEN], 1u);
            else XB_SPIN(xb_ld(&bar[XB_TOPGEN]) == tg, bar);
            __builtin_amdgcn_fence(__ATOMIC_ACQUIRE, "agent");
            xb_add(&bar[XB_XGEN(x)], 1u);
            asm volatile("s_waitcnt vmcnt(0)" ::: "memory");
        } else {
            XB_SPIN(xb_ld(&bar[XB_XGEN(x)]) == gen, bar);
            __builtin_amdgcn_fence(__ATOMIC_ACQUIRE, "agent");
            asm volatile("s_waitcnt vmcnt(0)" ::: "memory");
        }
    }
    __syncthreads();
}

__device__ __forceinline__ void block_seam() {
    asm volatile("s_waitcnt vmcnt(0)" ::: "memory");
    __syncthreads();
    if (tid_() == 0) { __builtin_amdgcn_fence(__ATOMIC_ACQUIRE, "agent"); asm volatile("s_waitcnt vmcnt(0)" ::: "memory"); }
    __syncthreads();
}

__device__ void ffn_fix_own_tiles(const int bid, const int nblk, bf16_t* __restrict__ H, const int nMt, const float* __restrict__ edge, const float* __restrict__ cw) {
    const int nwg = nMt * 4, q8 = nwg >> 3, r8 = nwg & 7, tid = tid_();
    for (long L = bid; L < nwg; L += nblk) {
        const int xcd = (int)L & 7, off = (int)L >> 3;
        const int w = (xcd < r8 ? xcd * (q8 + 1) : r8 * (q8 + 1) + (xcd - r8) * q8) + off;
        const int gid = w >> 5, lr = w & 31, pm = gid * 8 + (lr & 7);
        ffn_fix_tile(H, pm, nMt, edge, cw, tid);
    }
    block_seam();
}

__device__ void prologue_phase(const int bid, const int nblk, const int z0, const Params& p, float* smf) {
    transpose_job(bid, nblk, smf, p.in[5 + z0], p.wp[WP_FNET + z0], DM, DM, 1, 0, 1.0f);
    transpose_job(bid, nblk, smf, p.in[7 + z0], p.wp[WP_IN + z0], DM, 2 * DRNN, 1, 0, 1.0f);
    transpose_job(bid, nblk, smf, p.in[15 + z0], p.wp[WP_LOUT + z0], DRNN, DM, 1, 0, 1.0f);
    transpose_job(bid, nblk, smf, p.in[18 + z0], p.wp[WP_Q + z0], DM, DM, 2, (long)DM * DM, 0.0625f);
    transpose_job(bid, nblk, smf, p.in[19 + z0], p.wp[WP_KV + z0], DM, 2 * DM, 2, (long)2 * DM * DM, 1.0f);
    transpose_job(bid, nblk, smf, p.in[20 + z0], p.wp[WP_O + z0], DM, DM, 2, (long)DM * DM, 1.0f);
    transpose_job(bid, nblk, smf, p.in[22 + z0], p.wp[WP_UP + z0], DM, 2 * DFF, 2, (long)2 * DFF * DM, 1.0f);
    transpose_job(bid, nblk, smf, p.in[25 + z0], p.wp[WP_DOWN + z0], DFF, DM, 2, (long)DFF * DM, 1.0f);
    transpose_job(bid, nblk, smf, p.in[10 + z0], p.wp[WP_GATE + z0], 128, 128, 20, 256 * 128, 1.0f);
    transpose_job(bid, nblk, smf, p.in[12 + z0], p.wp[WP_GATE + z0] + 128 * 128, 128, 128, 20, 256 * 128, 1.0f);
    const long gtid = (long)bid * 512 + tid_(), gth = (long)nblk * 512;
    for (long i = gtid; i < 512 * 256; i += gth) { const int m = (int)(i >> 8), c = (int)(i & 255), cp = m >> 1; const int idx = (c * cp) & 255;
        const float ang = (float)idx * (1.0f / 128.0f); p.wp[WP_CS + z0][i] = f2bf(((m & 1) ? sinpif(ang) : cospif(ang)) * 0.0625f); }
    for (long i = gtid; i < (long)SEQ * 2 * SEQ; i += gth) { const int sp = (int)(i >> 12), k = (int)(i & 4095), s = k & 2047; const int idx = (sp * s) & 2047;
        const float ang = (float)idx * (1.0f / 1024.0f); p.wp[WP_DFTA + z0][i] = f2bf((k < SEQ ? cospif(ang) : -sinpif(ang)) * 0.022097086912f); }
    for (long i = gtid; i < 2 * DRNN; i += gth) p.c8sp[i] = 8.0f * log1pf(__expf(-p.in[14 + z0][i]));
    for (int l = 0; l < 2; ++l)
        rms_phase(bid, nblk, 0, (long)NB * NMEM, p.in[2 + z0], p.in[3 + z0], (long)16 * NMEM, p.in[17 + z0] + l * DM, p.wp[WP_MN + z0] + (long)l * NB * NMEM * DM, nullptr);
}

constexpr int NSTEP = 25;
__global__ __launch_bounds__(512, 2) void mega(Params p) {
    extern __shared__ __attribute__((aligned(16))) unsigned char shm[];
    cg::grid_group grid = cg::this_grid();
    volatile LAS unsigned* st = (volatile LAS unsigned*)((LAS unsigned char*)shm + (LDS_BYTES - 16));
    if (threadIdx.x == 0) { st[0] = 0u; st[1] = 0u; (void)xb_add(&p.bar[XB_XCNT(xb_xcc_id())], 1u); }
    grid.sync();
    const int total = 3 + p.nch * NSTEP;
    for (int pc = 0; pc < total; ++pc) {
        int z0; asm volatile("s_mov_b32 %0, 0" : "=s"(z0));
        const int bid = blockIdx.x + z0, nblk = gridDim.x + z0;
        int kind, arg, chunk;
        if (pc < 3) { kind = pc == 0 ? K_PROLOGUE : K_GEMM; arg = 17 + pc; chunk = 0; }
        else { const int q = pc - 3; chunk = q / NSTEP; const int s = q - chunk * NSTEP; kind = p.kind[s]; arg = p.arg[s]; }
        const int local_seam = arg >> 7; arg &= 0x7f;
        if (kind == K_GEMM) {
            if (arg == 1 && pc >= 3) dft_row1024_job(bid, nblk, (const bf16_t*)(p.R1 + z0), p.wp[WP_R0 + z0], p.CB + z0);
            if ((arg == 8 || arg == 14) && pc >= 3) ffn_fix_own_tiles(bid, nblk, (bf16_t*)(p.R1 + z0), (p.CB + z0) * 8, p.edge + z0, p.in[23 + z0] + (arg == 14 ? 3 * DFF : 0));
            gemm_phase(bid, nblk, (LAS unsigned char*)shm, arg, chunk, p);
        } else {
            const int CB = p.CB + z0; const long Tc = (long)CB * SEQ; const long r0 = (long)chunk * Tc;
            float* smf = (float*)shm;
            unsigned char* R1 = p.R1 + z0; bf16_t* R0 = p.wp[WP_R0 + z0]; float* out = p.out + z0;
#define IN(k) p.in[(k) + z0]
            switch (kind) {
                case K_PROLOGUE: prologue_phase(bid, nblk, z0, p, smf); break;
                case K_RMS_IN: rms_phase(bid, nblk, r0, Tc, IN(0), IN(1), (long)16 * SEQ, IN(4), R0, p.xr + z0); break;
                case K_RMS_MIX1: rms_bf_phase(bid, nblk, Tc, p.xr + z0, IN(4) + DM, R0); break;
                case K_RMS_XA: rms_bf_phase(bid, nblk, Tc, p.xr + z0, IN(16) + arg * DM, R0); break;
                case K_RMS_FFN: rms_bf_phase(bid, nblk, Tc, p.xr + z0, IN(21) + arg * DM, R0); break;
                case K_SOFTMAX: softmax_phase(bid, nblk, (const float*)(R1 + Tc * 2048), (bf16_t*)R1, Tc * 4); break;
                case K_FFNFIX: ffn_fix_phase(bid, nblk, (bf16_t*)R1, (int)(Tc / BM), p.edge + z0, IN(23) + arg * 3 * DFF); break;
                case K_FFNCONV: ffn_conv_phase(bid, nblk, (bf16_t*)R1, Tc, IN(23) + arg * 3 * DFF, IN(24) + arg * DFF); break;
                case K_LRUCONV: lru_conv_phase(bid, nblk, (const bf16_t*)R1, (bf16_t*)(R1 + Tc * 5120), Tc, IN(8), IN(9)); break;
                case K_LRU: lru_fused_phase(bid, nblk, (bf16_t*)R1, (bf16_t*)(R1 + Tc * 5120), p.wp[WP_GATE + z0], IN(8), IN(9), IN(11), IN(13), p.c8sp + z0, CB, (unsigned char*)shm); break;
                case K_SCAN: scan_phase(bid, nblk, (bf16_t*)R1, (const unsigned*)(R1 + Tc * 7680), Tc, CB, smf); break;
                case K_FINAL: final_norm_phase(bid, nblk, p.xr + z0, out + r0 * DM, Tc, IN(26)); break;
                default: break;
            }
#undef IN
        }
        if (local_seam) block_seam();
        else if (pc != 1 && pc != total - 1) xcd_barrier(p.bar + z0, st, (unsigned)nblk);
    }
}

static GemmDesc mkdesc(const void* A, const void* B, void* C, const float* bias, int nM, int nN, int nZ, int zdiv,
                       long aZ1, long aZ2, long bZ1, long bZ2, long aTile, long bTile, long cZ1, long cZ2, int csz,
                       long aCh, long bCh, long cCh, int K, int lda, int ldb, int ldc, int epi, int gelu_pn) {
    GemmDesc d{};
    d.A = (const char*)A; d.B = (const char*)B; d.C = (char*)C; d.bias = bias;
    d.aZ1 = (unsigned)(aZ1 * 2); d.aZ2 = (unsigned)(aZ2 * 2); d.bZ1 = (unsigned)(bZ1 * 2); d.bZ2 = (unsigned)(bZ2 * 2); d.aTile = (unsigned)(aTile * 2); d.bTile = (unsigned)(bTile * 2);
    d.cZ1 = (unsigned)(cZ1 * csz); d.cZ2 = (unsigned)(cZ2 * csz);
    d.aCh = (unsigned)(aCh * 2); d.bCh = (unsigned)(bCh * 2); d.cCh = (unsigned)(cCh * csz);
    d.bhalf = 128;
    { auto magic = [](unsigned dd) { return (unsigned)((0x100000000ull / dd) + 1ull); };
      d.mper = magic((unsigned)(nM * nN)); d.mnig = magic((unsigned)(8 * nN)); d.mgsz = magic((unsigned)(nM < 8 ? nM : 8)); d.mzdiv = zdiv > 1 ? magic((unsigned)zdiv) : 0u; d.padm = 0u; }
    d.nM = nM; d.nN = nN; d.nZ = nZ; d.zdiv = zdiv; d.K = K; d.lda = lda; d.ldb = ldb; d.ldc = ldc; d.epi = epi; d.gelu_pn = gelu_pn;
    return d;
}

extern "C" void kernel_launch(void* const* d_in, const int* in_sizes, int n_in, void* d_out, int out_size, void* d_ws, size_t ws_size, hipStream_t stream) {
    static int grid = 0;
    if (grid == 0) {
        int dev = 0, cus = 0, per_cu = 0;
        (void)hipGetDevice(&dev);
        (void)hipDeviceGetAttribute(&cus, hipDeviceAttributeMultiprocessorCount, dev);
        if (hipFuncSetAttribute((const void*)mega, hipFuncAttributeMaxDynamicSharedMemorySize, LDS_BYTES) != hipSuccess) { fprintf(stderr, "hipFuncSetAttribute failed\n"); }
        if (hipOccupancyMaxActiveBlocksPerMultiprocessor(&per_cu, (const void*)mega, 512, LDS_BYTES) != hipSuccess || per_cu < 1) per_cu = 1;
        (void)hipGetLastError();
        grid = cus * per_cu;
    }
    Params p{};
    for (int i = 0; i < 27; ++i) p.in[i] = (const float*)d_in[i];
    p.out = (float*)d_out;
    size_t off = 0; unsigned char* ws = (unsigned char*)d_ws;
    auto take = [&](size_t bytes) { unsigned char* r = ws + off; off += (bytes + 255) & ~(size_t)255; return r; };
    p.wp[WP_FNET] = (bf16_t*)take((size_t)DM * DM * 2);
    p.wp[WP_IN] = (bf16_t*)take((size_t)2 * DRNN * DM * 2);
    p.wp[WP_GATE] = (bf16_t*)take((size_t)20 * 256 * 128 * 2);
    p.wp[WP_LOUT] = (bf16_t*)take((size_t)DM * DRNN * 2);
    p.wp[WP_Q] = (bf16_t*)take((size_t)2 * DM * DM * 2);
    p.wp[WP_KV] = (bf16_t*)take((size_t)2 * 2 * DM * DM * 2);
    p.wp[WP_O] = (bf16_t*)take((size_t)2 * DM * DM * 2);
    p.wp[WP_UP] = (bf16_t*)take((size_t)2 * 2 * DFF * DM * 2);
    p.wp[WP_DOWN] = (bf16_t*)take((size_t)2 * DM * DFF * 2);
    p.wp[WP_CS] = (bf16_t*)take((size_t)512 * 256 * 2);
    p.wp[WP_DFTA] = (bf16_t*)take((size_t)SEQ * 2 * SEQ * 2);
    p.c8sp = (float*)take((size_t)2 * DRNN * 4);
    p.bar = (unsigned*)take((size_t)XCD_BAR_WORDS * 4);
    p.wp[WP_MN] = (bf16_t*)take((size_t)2 * NB * NMEM * DM * 2);
    bf16_t* Kmat = (bf16_t*)take((size_t)2 * NB * NMEM * DM * 2);
    bf16_t* VT = (bf16_t*)take((size_t)2 * NB * NMEM * DM * 2);
    const int cands[7] = {48, 24, 16, 8, 4, 2, 1};
    int CB = 1;
    for (int i = 0; i < 7; ++i) { const size_t need = off + (size_t)cands[i] * SEQ * (2048 + 7680 + 544 + 2048) + 8192; if (need <= ws_size) { CB = cands[i]; break; } }
    p.CB = CB; p.nch = NB / CB;
    const long Tc = (long)CB * SEQ; const int nMt = (int)(Tc / BM);
    p.wp[WP_R0] = (bf16_t*)take((size_t)Tc * 2048);
    p.R1 = take((size_t)Tc * 7680);
    p.edge = (float*)take((size_t)3 * nMt * 2 * DFF * 4);
    p.xr = (bf16_t*)take((size_t)Tc * 2048);
    bf16_t* XR = p.xr;
    bf16_t* R0 = p.wp[WP_R0]; unsigned char* R1 = p.R1;
    bf16_t* Ob = (bf16_t*)(R1 + Tc * 4096);
    bf16_t* YT = (bf16_t*)R1; bf16_t* Q = (bf16_t*)R1; bf16_t* Pb = (bf16_t*)(R1 + Tc * 2048); bf16_t* GV = (bf16_t*)R1;
    bf16_t* U = (bf16_t*)R1; bf16_t* cbuf = (bf16_t*)(R1 + Tc * 5120); bf16_t* LA = (bf16_t*)(R1 + Tc * 7680);
    float* out = p.out;
    const long MD = (long)NMEM * DM, SD = (long)SEQ * DM;
    p.g[0] = mkdesc(p.wp[WP_CS], R0, YT, nullptr, 2, 8, CB * 4, 4, 0, 0, SD, 256, 256 * 256, 256 * DM, (long)4 * 512 * SEQ, (long)512 * SEQ, 2, 0, 0, 0, 256, 256, DM, SEQ, E_BF16, 0);
    p.g[1] = mkdesc(p.wp[WP_DFTA], YT, R0, nullptr, 4, 4, CB, 1, 0, 0, (long)DM * 2 * SEQ, 0, (long)256 * 2 * SEQ, (long)256 * 2 * SEQ, SD, 0, 2, 0, 0, 0, 2 * SEQ, 2 * SEQ, 2 * SEQ, DM, E_DFT, 0);
    p.g[2] = mkdesc(R0, p.wp[WP_FNET], XR, p.in[6], nMt, 4, 1, 1, 0, 0, 0, 0, 256 * DM, 256 * DM, 0, 0, 2, 0, 0, 0, DM, DM, DM, DM, E_RESID, 0);
    for (int l = 0; l < 2; ++l) {
        const int b = 3 + l * 6;
        p.g[b + 0] = mkdesc(R0, p.wp[WP_Q] + (long)l * DM * DM, Q, nullptr, nMt, 4, 1, 1, 0, 0, 0, 0, 256 * DM, 256 * DM, 0, 0, 2, 0, 0, 0, DM, DM, DM, DM, E_BF16, 0);
        p.g[b + 1] = mkdesc(Q, Kmat + (long)l * NB * MD, Pb, nullptr, 8, 1, CB * 4, 4, SD, 256, MD, 256, 256 * DM, 0, SD, 256, 2, 0, (long)CB * MD, 0, 256, DM, DM, DM, E_SOFTMAX, 0);
        p.g[b + 2] = mkdesc(Pb, VT + (long)l * NB * MD, Ob, nullptr, 8, 1, CB * 4, 4, SD, 256, MD, (long)256 * NMEM, 256 * DM, 0, SD, 256, 2, 0, (long)CB * MD, 0, 256, DM, NMEM, DM, E_BF16, 0);
        p.g[b + 3] = mkdesc(Ob, p.wp[WP_O] + (long)l * DM * DM, XR, nullptr, nMt, 4, 1, 1, 0, 0, 0, 0, 256 * DM, 256 * DM, 0, 0, 2, 0, 0, 0, DM, DM, DM, DM, E_RESID, 0);
        p.g[b + 4] = mkdesc(R0, p.wp[WP_UP] + (long)l * 2 * DFF * DM, GV, nullptr, nMt, 22, 1, 1, 0, 0, 0, 0, 256 * DM, 128 * DM, 0, 0, 2, 0, 0, 0, DM, DM, DM, DFF, E_FFN, l);
        p.g[b + 4].bhalf = DFF;
        p.g[b + 5] = mkdesc(GV, p.wp[WP_DOWN] + (long)l * DM * DFF, XR, nullptr, nMt, 4, 1, 1, 0, 0, 0, 0, (long)256 * DFF, (long)256 * DFF, 0, 0, 2, 0, 0, 0, DFF, DFF, DFF, DM, E_RESID, 0);
    }
    p.g[15] = mkdesc(R0, p.wp[WP_IN], U, nullptr, nMt, 10, 1, 1, 0, 0, 0, 0, 256 * DM, 256 * DM, 0, 0, 2, 0, 0, 0, DM, DM, DM, 2 * DRNN, E_BF16, 5);
    p.g[16] = mkdesc(cbuf, p.wp[WP_GATE], LA, nullptr, nMt, 1, 20, 10, 0, 128, (long)10 * 256 * 128, (long)256 * 128, (long)256 * DRNN, 0, 0, 0, 2, 0, 0, 0, 128, DRNN, 128, DRNN, E_GATE, 0);
    p.g[17] = mkdesc(U, p.wp[WP_LOUT], XR, nullptr, nMt, 4, 1, 1, 0, 0, 0, 0, (long)256 * 2 * DRNN, (long)256 * DRNN, 0, 0, 2, 0, 0, 0, DRNN, 2 * DRNN, DRNN, DM, E_RESID, 0);
    p.g[18] = mkdesc(p.wp[WP_MN], p.wp[WP_KV], Kmat, nullptr, NB, 4, 2, 1, (long)NB * MD, 0, (long)2 * DM * DM, 0, 256 * DM, 256 * DM, (long)NB * MD, 0, 2, 0, 0, 0, DM, DM, DM, DM, E_BF16, 0);
    p.g[19] = mkdesc(p.wp[WP_KV] + (long)DM * DM, p.wp[WP_MN], VT, nullptr, 4, 1, 2 * NB, NB, (long)2 * DM * DM, 0, (long)NB * MD, MD, 256 * DM, 0, (long)NB * MD, MD, 2, 0, 0, 0, DM, DM, DM, NMEM, E_BF16, 0);
    p.g[1].padm = 1u;
    for (int l = 0; l < 2; ++l) { const int b = 3 + l * 6; p.g[b + 0].padm = 1u; p.g[b + 1].padm = 1u; p.g[b + 2].padm = 1u;
                                  p.g[b + 4].padm = 1u; }
    p.g[15].padm = 1u;
    const unsigned char kinds[NSTEP] = {K_RMS_IN, K_GEMM, K_GEMM, K_GEMM, K_RMS_XA, K_GEMM, K_GEMM, K_GEMM, K_GEMM, K_RMS_FFN, K_GEMM, K_GEMM,
                                         K_RMS_MIX1, K_GEMM, K_LRU, K_GEMM, K_RMS_XA, K_GEMM, K_GEMM, K_GEMM, K_GEMM, K_RMS_FFN, K_GEMM, K_GEMM, K_FINAL};
    const unsigned char LS = 0x80;
    const unsigned char args_[NSTEP] = {0, 0, 1, 2, 0, (unsigned char)(3 | LS), (unsigned char)(4 | LS), 5, 6, 0, 7, 8,
                                         0, 15, 0, 17, 1, (unsigned char)(9 | LS), (unsigned char)(10 | LS), 11, 12, 1, 13, 14, 0};
    for (int i = 0; i < NSTEP; ++i) { p.kind[i] = kinds[i]; p.arg[i] = args_[i]; }
    (void)hipMemsetAsync(p.bar, 0, (size_t)XCD_BAR_WORDS * 4, stream);
    void* args[] = {&p};
    hipError_t e = hipLaunchCooperativeKernel((const void*)mega, dim3(grid), dim3(512), args, LDS_BYTES, stream);
    if (e != hipSuccess) fprintf(stderr, "cooperative launch failed: %s (grid %d)\n", hipGetErrorString(e), grid);
}
```
